# Optimizing an MI355X kernel written in HIP

```python
import jax, jax.numpy as jnp
from jax import lax
import numpy as np

D_MODEL = 2048
BATCH = 4
SEQ = 2048
DEPTH = 1

D_MIX = D_MODEL
D_LRU = D_MIX // 2
D_RWKV = D_MIX - D_LRU
LRU_HEADS = 4
LRU_HEAD_DIM = D_LRU // LRU_HEADS
CONV_WIDTH = 4
LRU_C = 8.0
RWKV_HEAD_DIM = 64
RWKV_HEADS = D_RWKV // RWKV_HEAD_DIM
W_LORA = 64
A_LORA = 64
G_LORA = 160
RWKV_PROJ_W = 3 * D_RWKV + W_LORA + A_LORA + G_LORA
IN_W = 2 * D_LRU + RWKV_PROJ_W
D_FF = -(-8 * D_MODEL // (3 * 256)) * 256
N_MOD = 6
RMS_EPS = 1e-6
GN_EPS = 64e-5
L2_EPS = 1e-12

kernel_name = "hybrid_rglru_rwkv7_adaln_layer"

_IN_SPLITS = [D_LRU, 2 * D_LRU]
_RWKV_SPLITS = [int(s) for s in np.cumsum([D_RWKV, D_RWKV, D_RWKV, W_LORA, A_LORA])]


def rms_norm(x, g):
    xf = x.astype(jnp.float32)
    y = xf * lax.rsqrt(jnp.mean(xf * xf, axis=-1, keepdims=True) + RMS_EPS)
    return (y * g.astype(jnp.float32)).astype(x.dtype)


def modulate(h, shift, scale):
    return h * (1.0 + scale[:, None, :]) + shift[:, None, :]


def shift_prev(p):
    return jnp.pad(p[:, :-1], ((0, 0), (1, 0), (0, 0)))


def causal_depthwise_conv(u, w, b):
    S = u.shape[1]
    up = jnp.pad(u, ((0, 0), (CONV_WIDTH - 1, 0), (0, 0)))
    y = b
    for k in range(CONV_WIDTH):
        y = y + up[:, k:k + S] * w[k]
    return y


def _linear_scan_combine(c1, c2):
    a1, b1 = c1
    a2, b2 = c2
    return a1 * a2, a2 * b1 + b2


def rg_lru(u, wa, ba, wx, bx, lam):
    B, S, _ = u.shape
    uf = u.astype(jnp.float32)
    uh = uf.reshape(B, S, LRU_HEADS, LRU_HEAD_DIM)
    r = jax.nn.sigmoid(jnp.einsum('bshi,hij->bshj', uh, wa.astype(jnp.float32)).reshape(B, S, D_LRU) + ba)
    i = jax.nn.sigmoid(jnp.einsum('bshi,hij->bshj', uh, wx.astype(jnp.float32)).reshape(B, S, D_LRU) + bx)
    log_a = -LRU_C * r * jax.nn.softplus(-lam.astype(jnp.float32))
    a = jnp.exp(log_a)
    mult = jnp.sqrt(1.0 - jnp.exp(2.0 * log_a))
    is_first = (jnp.arange(S) == 0)[None, :, None]
    mult = jnp.where(is_first, 1.0, mult)
    b = mult * (i * uf)
    _, h = lax.associative_scan(_linear_scan_combine, (a, b), axis=1)
    return h.astype(u.dtype)


def rwkv7_recurrence(r, log_decay, k, v, kk, a):
    B, S, H, N = r.shape
    decay = jnp.exp(log_decay)

    def step(state, inp):
        r_t, d_t, k_t, v_t, kk_t, a_t = inp
        sa = jnp.einsum('bhvk,bhk->bhv', state, -kk_t)
        state = (state * d_t[:, :, None, :]
                 + sa[..., None] * (kk_t * a_t)[:, :, None, :]
                 + v_t[..., None] * k_t[:, :, None, :])
        y_t = jnp.einsum('bhvk,bhk->bhv', state, r_t)
        return state, y_t

    xs = tuple(jnp.moveaxis(t, 1, 0) for t in (r, decay, k, v, kk, a))
    s0 = jnp.zeros((B, H, N, N), jnp.float32)
    _, y = lax.scan(step, s0, xs)
    return jnp.moveaxis(y, 0, 1)


def rwkv7_mix(p, mu, w0, w2, a0, a2, g2, k_k, k_a, r_k, ln_g, ln_b):
    B, S, _ = p.shape
    dt = p.dtype
    p = p + (shift_prev(p) - p) * mu
    r, k, v, wl, al, gl = jnp.split(p, _RWKV_SPLITS, axis=-1)
    w = -jax.nn.softplus(-(w0 + jnp.tanh(wl) @ w2)) - 0.5
    log_decay = -jnp.exp(w.astype(jnp.float32))
    a = jax.nn.sigmoid(a0 + al @ a2)
    g = jax.nn.sigmoid(gl) @ g2
    hs = (B, S, RWKV_HEADS, RWKV_HEAD_DIM)
    kk = (k * k_k).astype(jnp.float32).reshape(hs)
    kk = kk / jnp.maximum(jnp.linalg.norm(kk, axis=-1, keepdims=True), L2_EPS)
    k = k * (1.0 + (a - 1.0) * k_a)
    rf = r.astype(jnp.float32).reshape(hs)
    kf = k.astype(jnp.float32).reshape(hs)
    vf = v.astype(jnp.float32).reshape(hs)
    af = a.astype(jnp.float32).reshape(hs)
    y = rwkv7_recurrence(rf, log_decay.reshape(hs), kf, vf, kk, af)
    mean = jnp.mean(y, axis=-1, keepdims=True)
    var = jnp.mean(jnp.square(y - mean), axis=-1, keepdims=True)
    y = ((y - mean) * lax.rsqrt(var + GN_EPS)).reshape(B, S, D_RWKV)
    y = y * ln_g.astype(jnp.float32) + ln_b.astype(jnp.float32)
    bonus = jnp.sum(rf * kf * r_k.astype(jnp.float32), axis=-1, keepdims=True) * vf
    y = y + bonus.reshape(B, S, D_RWKV)
    return (y * g.astype(jnp.float32)).astype(dt)


def setup_inputs(seed: int = 0) -> dict:
    key = jax.random.key(seed)
    ks = iter(jax.random.split(key, 32))
    nrm = lambda shape, s: jax.random.normal(next(ks), shape, jnp.float32) * s
    L = DEPTH
    u = jax.random.uniform(next(ks), (L, D_LRU), jnp.float32, 0.9, 0.999)
    base = u ** (1.0 / LRU_C)
    lru_lambda = jnp.log(base) - jnp.log1p(-base)
    return {
        "x": nrm((BATCH, SEQ, D_MODEL), 1.0),
        "c": nrm((BATCH, D_MODEL), 1.0),
        "w_ada": nrm((L, D_MODEL, N_MOD * D_MODEL), 0.5 * D_MODEL ** -0.5),
        "b_ada": nrm((L, N_MOD * D_MODEL), 0.02),
        "norm_mix_g": 1.0 + nrm((L, D_MODEL), 0.02),
        "w_in": nrm((L, D_MODEL, IN_W), D_MODEL ** -0.5),
        "conv_w": nrm((L, CONV_WIDTH, D_LRU), CONV_WIDTH ** -0.5),
        "conv_b": nrm((L, D_LRU), 0.01),
        "lru_wa": nrm((L, LRU_HEADS, LRU_HEAD_DIM, LRU_HEAD_DIM), LRU_HEAD_DIM ** -0.5),
        "lru_ba": nrm((L, D_LRU), 0.01),
        "lru_wx": nrm((L, LRU_HEADS, LRU_HEAD_DIM, LRU_HEAD_DIM), LRU_HEAD_DIM ** -0.5),
        "lru_bx": nrm((L, D_LRU), 0.01),
        "lru_lambda": lru_lambda,
        "rwkv_mu": jax.random.uniform(next(ks), (L, RWKV_PROJ_W), jnp.float32),
        "rwkv_w0": jax.random.uniform(next(ks), (L, D_RWKV), jnp.float32, -6.5, -1.5),
        "rwkv_w2": nrm((L, W_LORA, D_RWKV), W_LORA ** -0.5),
        "rwkv_a0": nrm((L, D_RWKV), 0.5),
        "rwkv_a2": nrm((L, A_LORA, D_RWKV), A_LORA ** -0.5),
        "rwkv_g2": nrm((L, G_LORA, D_RWKV), G_LORA ** -0.5),
        "rwkv_k_k": 0.85 + nrm((L, D_RWKV), 0.05),
        "rwkv_k_a": 1.0 + nrm((L, D_RWKV), 0.05),
        "rwkv_r_k": nrm((L, RWKV_HEADS, RWKV_HEAD_DIM), 0.1),
        "rwkv_ln_g": 1.0 + nrm((L, D_RWKV), 0.02),
        "rwkv_ln_b": nrm((L, D_RWKV), 0.01),
        "w_out": nrm((L, D_MIX, D_MODEL), D_MIX ** -0.5),
        "norm_ffn_g": 1.0 + nrm((L, D_MODEL), 0.02),
        "w_gu": nrm((L, D_MODEL, 2 * D_FF), D_MODEL ** -0.5),
        "w_down": nrm((L, D_FF, D_MODEL), D_FF ** -0.5),
        "final_norm_g": 1.0 + nrm((D_MODEL,), 0.02),
    }


def reference(x, c, w_ada, b_ada, norm_mix_g, w_in, conv_w, conv_b, lru_wa, lru_ba,
              lru_wx, lru_bx, lru_lambda, rwkv_mu, rwkv_w0, rwkv_w2, rwkv_a0, rwkv_a2,
              rwkv_g2, rwkv_k_k, rwkv_k_a, rwkv_r_k, rwkv_ln_g, rwkv_ln_b, w_out,
              norm_ffn_g, w_gu, w_down, final_norm_g):
    c_act = jax.nn.silu(c)
    for l in range(DEPTH):
        mod = c_act @ w_ada[l] + b_ada[l]
        sh_m, sc_m, g_m, sh_f, sc_f, g_f = jnp.split(mod, N_MOD, axis=-1)

        h = modulate(rms_norm(x, norm_mix_g[l]), sh_m, sc_m)
        p = h @ w_in[l]
        p_lru, p_gate, p_rwkv = jnp.split(p, _IN_SPLITS, axis=-1)
        u = causal_depthwise_conv(p_lru, conv_w[l], conv_b[l])
        y_a = rg_lru(u, lru_wa[l], lru_ba[l], lru_wx[l], lru_bx[l], lru_lambda[l]) * jax.nn.gelu(p_gate)
        y_b = rwkv7_mix(p_rwkv, rwkv_mu[l], rwkv_w0[l], rwkv_w2[l], rwkv_a0[l], rwkv_a2[l],
                        rwkv_g2[l], rwkv_k_k[l], rwkv_k_a[l], rwkv_r_k[l], rwkv_ln_g[l], rwkv_ln_b[l])
        mix = jnp.concatenate([y_a, y_b], axis=-1) @ w_out[l]
        x = x + g_m[:, None, :] * mix

        h = modulate(rms_norm(x, norm_ffn_g[l]), sh_f, sc_f)
        gate, up = jnp.split(h @ w_gu[l], 2, axis=-1)
        x = x + g_f[:, None, :] * ((jax.nn.silu(gate) * up) @ w_down[l])
    return rms_norm(x, final_norm_g)
```

```cpp
#include <hip/hip_runtime.h>
#include <cstdio>
#include <cstdint>

#ifndef MK_N_LAUNCHES
#define MK_N_LAUNCHES 1
#endif

namespace pg8 {
#define PG8_LAS __attribute__((address_space(3)))
typedef unsigned short bf16_t;
typedef short bf16x8 __attribute__((ext_vector_type(8)));
typedef float f32x4 __attribute__((ext_vector_type(4)));
typedef float f32x2 __attribute__((ext_vector_type(2)));
typedef unsigned u32x4 __attribute__((ext_vector_type(4)));
typedef unsigned u32x2 __attribute__((ext_vector_type(2)));
constexpr int BM = 256, BK = 64, HALF = 128, HTB = HALF * BK * 2, STAGE_BYTES = 8 * HTB, NXCD = 8, WGM = 8;

__host__ __device__ __forceinline__ int lds_byte(int r, int c) { const int st = (r >> 4) * 2 + (c >> 5), rr = r & 15, cc = c & 31, ob = rr * 64 + cc * 2; return st * 1024 + (ob ^ (((ob >> 9) & 1) << 5)); }
__host__ __device__ __forceinline__ void stage_rc(int b, int& R, int& C) { const int st = b / 1024, sb = b % 1024, swz = sb ^ (((sb >> 9) & 1) << 5); R = (st >> 1) * 16 + swz / 64; C = (st & 1) * 32 + (swz % 64) / 2; }
__host__ __device__ __forceinline__ int perm32(int rho) { const int n = rho >> 4, i = rho & 15; return 8 * (i >> 2) + 4 * n + (i & 3); }

struct Unit { int pm, pn, z; };
struct Gemm { const bf16_t* A; const bf16_t* Bt; int lda, ldb, K; long zA, zB; };

struct StaticOrder {
    int nM, nN, nwg, G, c;
    __host__ __device__ void init(int M, int N, int G_, int c_) { nM = M / BM; nN = N / BM; nwg = nM * nN; G = G_; c = c_; }
    __host__ __device__ bool next(int i, Unit& u) const {
        const long L = (long)i * G + c; if (L >= nwg) return false;
        int wgid = (int)L; { const int q = nwg / NXCD, r = nwg % NXCD, xcd = wgid % NXCD, off = wgid / NXCD; wgid = (xcd < r ? xcd * (q + 1) : r * (q + 1) + (xcd - r) * q) + off; }
        const int nig = WGM * nN, gid = wgid / nig, fm = gid * WGM, gsz = (nM - fm) < WGM ? (nM - fm) : WGM;
        u.pm = fm + ((wgid % nig) % gsz); u.pn = (wgid % nig) / gsz; u.z = 0; return true;
    }
};
struct LruOrder {
    int G, c;
    __host__ __device__ bool next(int i, Unit& u) const { const int L = i * G + c; if (L >= 256) return false; u.z = L >> 6; u.pm = (L & 63) >> 1; u.pn = L & 1; return true; }
};

__device__ __forceinline__ unsigned cvt_pk_bf16(float lo, float hi) { unsigned r; asm volatile("v_cvt_pk_bf16_f32 %0, %1, %2" : "=v"(r) : "v"(lo), "v"(hi)); return r; }
__device__ __forceinline__ float fast_sigmoid(float x) { return __builtin_amdgcn_rcpf(1.0f + __builtin_amdgcn_exp2f(-1.44269504089f * x)); }
__device__ __forceinline__ float gelu_tanh(float x) { const float t = x + 0.044715f * x * x * x; return x * __builtin_amdgcn_rcpf(1.0f + __builtin_amdgcn_exp2f(-2.30220819814f * t)); }
__device__ __forceinline__ float bf_lo(unsigned w) { return __uint_as_float(w << 16); }
__device__ __forceinline__ float bf_hi(unsigned w) { return __uint_as_float(w & 0xffff0000u); }

struct EpiP {
    static constexpr bool PERM = true;
    bf16_t* O; int ldc;
    __device__ __forceinline__ void operator()(f32x4 (&acc)[2][2][4][2], const Unit& u, int wr, int wc, int fr, int fq) const {
        const int row0 = u.pm * BM + wr * 64 + fr, col0 = u.pn * BM + wc * 32 + 8 * fq;
        const bool gel = (u.pn >= 4 && u.pn < 8);
#pragma unroll
        for (int ai = 0; ai < 2; ++ai)
#pragma unroll
            for (int m = 0; m < 4; ++m) { bf16_t* rowp = O + (size_t)(row0 + ai * HALF + m * 16) * ldc + col0;
#pragma unroll
                for (int bj = 0; bj < 2; ++bj) { f32x4 v0 = acc[ai][bj][m][0], v1 = acc[ai][bj][m][1];
                    if (gel) {
#pragma unroll
                        for (int i = 0; i < 4; ++i) { v0[i] = gelu_tanh(v0[i]); v1[i] = gelu_tanh(v1[i]); } }
                    u32x4 w; w.x = cvt_pk_bf16(v0[0], v0[1]); w.y = cvt_pk_bf16(v0[2], v0[3]); w.z = cvt_pk_bf16(v1[0], v1[1]); w.w = cvt_pk_bf16(v1[2], v1[3]);
                    *(u32x4*)(rowp + bj * HALF) = w; } }
    }
};
struct EpiRes {
    static constexpr bool PERM = false;
    const float* base; float* out; const float* gate; int ldc; int gstride;
    __device__ __forceinline__ void operator()(f32x4 (&acc)[2][2][4][2], const Unit& u, int wr, int wc, int fr, int fq) const {
        const int row0 = u.pm * BM + wr * 64 + fr, col0 = u.pn * BM + wc * 32 + 4 * fq;
        const float* g = gate + (size_t)(u.pm >> 3) * gstride;
        f32x4 gv[2][2];
#pragma unroll
        for (int bj = 0; bj < 2; ++bj)
#pragma unroll
            for (int n = 0; n < 2; ++n) gv[bj][n] = *(const f32x4*)(g + col0 + bj * HALF + n * 16);
#pragma unroll
        for (int ai = 0; ai < 2; ++ai)
#pragma unroll
            for (int m = 0; m < 4; ++m) { const size_t off = (size_t)(row0 + ai * HALF + m * 16) * ldc + col0;
#pragma unroll
                for (int bj = 0; bj < 2; ++bj)
#pragma unroll
                    for (int n = 0; n < 2; ++n) { const f32x4 b = *(const f32x4*)(base + off + bj * HALF + n * 16);
                        *(f32x4*)(out + off + bj * HALF + n * 16) = b + gv[bj][n] * acc[ai][bj][m][n]; } }
    }
};
struct EpiSwiglu {
    static constexpr bool PERM = true;
    bf16_t* O; int ldc;
    __device__ __forceinline__ void operator()(f32x4 (&acc)[2][2][4][2], const Unit& u, int wr, int wc, int fr, int fq) const {
        const int row0 = u.pm * BM + wr * 64 + fr, col0 = u.pn * HALF + wc * 32 + 8 * fq;
#pragma unroll
        for (int ai = 0; ai < 2; ++ai)
#pragma unroll
            for (int m = 0; m < 4; ++m) { bf16_t* rowp = O + (size_t)(row0 + ai * HALF + m * 16) * ldc + col0;
                f32x4 o0, o1;
#pragma unroll
                for (int i = 0; i < 4; ++i) { const float g0 = acc[ai][0][m][0][i], g1 = acc[ai][0][m][1][i];
                    o0[i] = g0 * fast_sigmoid(g0) * acc[ai][1][m][0][i]; o1[i] = g1 * fast_sigmoid(g1) * acc[ai][1][m][1][i]; }
                u32x4 w; w.x = cvt_pk_bf16(o0[0], o0[1]); w.y = cvt_pk_bf16(o0[2], o0[3]); w.z = cvt_pk_bf16(o1[0], o1[1]); w.w = cvt_pk_bf16(o1[2], o1[3]);
                *(u32x4*)rowp = w; }
    }
};
struct EpiLora {
    static constexpr bool PERM = false;
    float* DEC; float* AA; bf16_t* GG; const float* w0; const float* a0;
    __device__ __forceinline__ void operator()(f32x4 (&acc)[2][2][4][2], const Unit& u, int wr, int wc, int fr, int fq) const {
        const int row0 = u.pm * BM + wr * 64 + fr, blk = u.pn >> 2, col0 = (u.pn & 3) * BM + wc * 32 + 4 * fq;
        if (blk == 2) {
#pragma unroll
            for (int ai = 0; ai < 2; ++ai)
#pragma unroll
                for (int m = 0; m < 4; ++m) { const size_t off = (size_t)(row0 + ai * HALF + m * 16) * 1024 + col0;
#pragma unroll
                    for (int bj = 0; bj < 2; ++bj)
#pragma unroll
                        for (int n = 0; n < 2; ++n) { const f32x4 v = acc[ai][bj][m][n]; u32x2 w; w.x = cvt_pk_bf16(v[0], v[1]); w.y = cvt_pk_bf16(v[2], v[3]);
                            *(u32x2*)(GG + off + bj * HALF + n * 16) = w; } }
        } else {
            const float* bias = blk == 0 ? w0 : a0; float* dst = blk == 0 ? DEC : AA;
            f32x4 bv[2][2];
#pragma unroll
            for (int bj = 0; bj < 2; ++bj)
#pragma unroll
                for (int n = 0; n < 2; ++n) bv[bj][n] = *(const f32x4*)(bias + col0 + bj * HALF + n * 16);
#pragma unroll
            for (int ai = 0; ai < 2; ++ai)
#pragma unroll
                for (int m = 0; m < 4; ++m) { const size_t off = (size_t)(row0 + ai * HALF + m * 16) * 1024 + col0;
#pragma unroll
                    for (int bj = 0; bj < 2; ++bj)
#pragma unroll
                        for (int n = 0; n < 2; ++n) { f32x4 v = acc[ai][bj][m][n] + bv[bj][n];
#pragma unroll
                            for (int i = 0; i < 4; ++i) { const float s = fast_sigmoid(v[i]); v[i] = blk == 0 ? __builtin_amdgcn_exp2f(-0.875053840f * s) : s; }
                            *(f32x4*)(dst + off + bj * HALF + n * 16) = v; } }
        }
    }
};
__device__ __forceinline__ float dpp_shr(float x, float fill, int d) {
    const int xi = __float_as_int(x), fi = __float_as_int(fill); int r;
    switch (d) { case 1: r = __builtin_amdgcn_update_dpp(fi, xi, 0x111, 0xf, 0xf, false); break; case 2: r = __builtin_amdgcn_update_dpp(fi, xi, 0x112, 0xf, 0xf, false); break;
                 case 4: r = __builtin_amdgcn_update_dpp(fi, xi, 0x114, 0xf, 0xf, false); break; default: r = __builtin_amdgcn_update_dpp(fi, xi, 0x118, 0xf, 0xf, false); break; }
    return __int_as_float(r);
}
struct EpiLru {
    static constexpr bool PERM = false;
    const bf16_t* U; const float* ba; const float* bx; const float* lam; bf16_t* HLOC; bf16_t* PCUM; float* PSEG; float* HSEG;
    __device__ __forceinline__ void operator()(f32x4 (&acc)[2][2][4][2], const Unit& u, int wr, int wc, int fr, int fq) const {
        const int lane = fq * 16 + fr;
        const int c0 = u.z * 256 + u.pn * HALF + wc * 32 + 4 * fq;
        f32x4 ba4[2], bx4[2], c8[2];
#pragma unroll
        for (int n = 0; n < 2; ++n) { ba4[n] = *(const f32x4*)(ba + c0 + 16 * n); bx4[n] = *(const f32x4*)(bx + c0 + 16 * n); const f32x4 l = *(const f32x4*)(lam + c0 + 16 * n);
#pragma unroll
            for (int i = 0; i < 4; ++i) { const float z = -l[i]; c8[n][i] = 8.0f * (fmaxf(z, 0.f) + log1pf(__expf(-fabsf(z)))); } }
        const int bsrc = ((lane & 48) | 15) << 2;
#pragma unroll
        for (int ai = 0; ai < 2; ++ai) {
            const int t0 = u.pm * BM + ai * HALF + wr * 64;
            f32x4 cA[2], cB[2];
#pragma unroll
            for (int n = 0; n < 2; ++n) { cA[n] = (f32x4){1.f, 1.f, 1.f, 1.f}; cB[n] = (f32x4){0.f, 0.f, 0.f, 0.f}; }
#pragma unroll
            for (int m = 0; m < 4; ++m) { const int t = t0 + 16 * m + fr; const bool first = (t & 2047) == 0;
#pragma unroll
                for (int n = 0; n < 2; ++n) { const u32x2 uw = *(const u32x2*)(U + (size_t)t * 1024 + c0 + 16 * n);
                    const float uu[4] = {bf_lo(uw.x), bf_hi(uw.x), bf_lo(uw.y), bf_hi(uw.y)};
                    f32x4 A, B;
#pragma unroll
                    for (int i = 0; i < 4; ++i) { const float r = fast_sigmoid(acc[ai][0][m][n][i] + ba4[n][i]), ig = fast_sigmoid(acc[ai][1][m][n][i] + bx4[n][i]);
                        const float la = -c8[n][i] * r, a = __expf(la), x2 = 2.0f * la;
                        float om;
                        if (x2 > -0.25f) { float q = 1.0f / 5040.0f; q = q * x2 + 1.0f / 720.0f; q = q * x2 + 1.0f / 120.0f; q = q * x2 + 1.0f / 24.0f; q = q * x2 + 1.0f / 6.0f; q = q * x2 + 0.5f; q = q * x2 + 1.0f; om = -(q * x2); }
                        else om = 1.0f - a * a;
                        const float mult = first ? 1.0f : sqrtf(om);
                        float a_ = a, b_ = mult * ig * uu[i];
#pragma unroll
                        for (int d = 1; d < 16; d <<= 1) { const float ap = dpp_shr(a_, 1.0f, d), bp = dpp_shr(b_, 0.0f, d); b_ = a_ * bp + b_; a_ = a_ * ap; }
                        b_ = a_ * cB[n][i] + b_; a_ = a_ * cA[n][i];
                        A[i] = a_; B[i] = b_; }
#pragma unroll
                    for (int i = 0; i < 4; ++i) { cA[n][i] = __int_as_float(__builtin_amdgcn_ds_bpermute(bsrc, __float_as_int(A[i]))); cB[n][i] = __int_as_float(__builtin_amdgcn_ds_bpermute(bsrc, __float_as_int(B[i]))); }
                    u32x2 hw, pw; hw.x = cvt_pk_bf16(B[0], B[1]); hw.y = cvt_pk_bf16(B[2], B[3]); pw.x = cvt_pk_bf16(A[0], A[1]); pw.y = cvt_pk_bf16(A[2], A[3]);
                    *(u32x2*)(HLOC + (size_t)t * 1024 + c0 + 16 * n) = hw; *(u32x2*)(PCUM + (size_t)t * 1024 + c0 + 16 * n) = pw; } }
            if (fr == 0) { const int seg = t0 >> 6;
#pragma unroll
                for (int n = 0; n < 2; ++n) { *(f32x4*)(PSEG + (size_t)seg * 1024 + c0 + 16 * n) = cA[n]; *(f32x4*)(HSEG + (size_t)seg * 1024 + c0 + 16 * n) = cB[n]; } }
        }
    }
};

template <class Epi, class Sched, bool ALIGN_EPI = false>
__device__ __forceinline__ void gemm_phase(PG8_LAS unsigned char* lds, const Gemm g, const Sched& S, const Epi& E) {
    const int tid = threadIdx.x, wid = __builtin_amdgcn_readfirstlane(tid >> 6), lane = tid & 63, wr = wid >> 2, wc = wid & 3, fr = lane & 15, fq = lane >> 4;
    int K_ = g.K; asm volatile("" : "+s"(K_));
    const int K = K_, nt = K / BK;
    unsigned voffA[2], voffB[2];
#pragma unroll
    for (int i = 0; i < 2; ++i) { int R, C; stage_rc(tid * 16 + i * 8192, R, C); const int Rb = Epi::PERM ? ((R & ~31) + perm32(R & 31)) : R;
        voffA[i] = (unsigned)(R * g.lda + C) * 2u; voffB[i] = (unsigned)(Rb * g.ldb + C) * 2u; }
    const size_t kstep = (size_t)(BK * 2);
    const size_t hstepA = (size_t)HALF * g.lda * 2, hstepB = (size_t)HALF * g.ldb * 2;
    const size_t tstepA = 2 * hstepA, tstepB = 2 * hstepB;
    const unsigned ldsw = (unsigned)wid * 1024u;
    const int aoff = lds_byte(wr * 64 + fr, fq * 8), boff = lds_byte(wc * 32 + fr, fq * 8);
#define PG8_SA(b, h) (((b) * 2 + (h)) * HTB)
#define PG8_SB(b, h) ((4 + (b) * 2 + (h)) * HTB)
#define PG8_STAGE(bufoff, gbase, voff) do { _Pragma("unroll") for (int _i = 0; _i < 2; ++_i) \
        __builtin_amdgcn_global_load_lds((const unsigned*)((const char*)(gbase) + (voff)[_i]), (PG8_LAS unsigned*)(lds + (bufoff) + ldsw + _i * 8192), 16, 0, 0); } while (0)
#define PG8_LDA(dst, b, h) do { _Pragma("unroll") for (int m = 0; m < 4; ++m) _Pragma("unroll") for (int k = 0; k < 2; ++k) dst[m][k] = *(const PG8_LAS bf16x8*)(lds + PG8_SA(b, h) + aoff + m * 2048 + k * 1024); } while (0)
#define PG8_LDB(dst, b, h) do { _Pragma("unroll") for (int n = 0; n < 2; ++n) _Pragma("unroll") for (int k = 0; k < 2; ++k) dst[n][k] = *(const PG8_LAS bf16x8*)(lds + PG8_SB(b, h) + boff + n * 2048 + k * 1024); } while (0)
#define PG8_MMA(ai, bj, At, Bt) do { __builtin_amdgcn_s_setprio(1); _Pragma("unroll") for (int m = 0; m < 4; ++m) _Pragma("unroll") for (int n = 0; n < 2; ++n) _Pragma("unroll") for (int k = 0; k < 2; ++k) \
        acc[ai][bj][m][n] = __builtin_amdgcn_mfma_f32_16x16x32_bf16(Bt[n][k], At[m][k], acc[ai][bj][m][n], 0, 0, 0); __builtin_amdgcn_s_setprio(0); } while (0)
#define PG8_WAIT_V(n) asm volatile("s_waitcnt vmcnt(" #n ")" ::: "memory")
#define PG8_WAIT_L(n) asm volatile("s_waitcnt lgkmcnt(" #n ")" ::: "memory")
#define PG8_BAR __builtin_amdgcn_s_barrier()
#define PG8_SCHED __builtin_amdgcn_sched_barrier(0)
    Unit cur, nxt; int ui = 0;
    if (!S.next(0, cur)) return;
    f32x4 acc[2][2][4][2];
#pragma unroll
    for (int a = 0; a < 2; ++a)
#pragma unroll
        for (int b = 0; b < 2; ++b)
#pragma unroll
            for (int m = 0; m < 4; ++m)
#pragma unroll
                for (int n = 0; n < 2; ++n) acc[a][b][m][n] = (f32x4){0.f, 0.f, 0.f, 0.f};
    bf16x8 At[4][2], B0[2][2], B1[2][2];
    const char* cA = (const char*)(g.A + cur.z * g.zA) + (size_t)cur.pm * tstepA; const char* cB = (const char*)(g.Bt + cur.z * g.zB) + (size_t)cur.pn * tstepB;
    PG8_STAGE(PG8_SB(0, 0), cB, voffB); PG8_STAGE(PG8_SB(0, 1), cB + hstepB, voffB); PG8_STAGE(PG8_SA(0, 0), cA, voffA); PG8_STAGE(PG8_SA(0, 1), cA + hstepA, voffA);
    if (wr == 1) PG8_BAR;
    PG8_WAIT_V(2); PG8_BAR;
    PG8_STAGE(PG8_SB(1, 0), cB + kstep, voffB); PG8_STAGE(PG8_SA(1, 0), cA + kstep, voffA); PG8_STAGE(PG8_SB(1, 1), cB + hstepB + kstep, voffB);
    PG8_WAIT_V(6); PG8_BAR;
    for (;;) {
        const bool has_next = S.next(ui + 1, nxt);
        const char* nA = has_next ? (const char*)(g.A + nxt.z * g.zA) + (size_t)nxt.pm * tstepA : cA; const char* nB = has_next ? (const char*)(g.Bt + nxt.z * g.zB) + (size_t)nxt.pn * tstepB : cB;
        for (int t = 0; t < nt; t += 2) {
            const bool last = (t == nt - 2);
            const char* a1 = cA + (size_t)(t + 1) * kstep;
            const char* a2 = last ? nA : cA + (size_t)(t + 2) * kstep; const char* b2 = last ? nB : cB + (size_t)(t + 2) * kstep;
            const char* a3 = a2 + kstep; const char* b3 = b2 + kstep;
            PG8_LDB(B0, 0, 0); PG8_LDB(B1, 0, 1); PG8_SCHED; PG8_LDA(At, 0, 0); PG8_STAGE(PG8_SA(1, 1), a1 + hstepA, voffA);
            PG8_WAIT_V(8); PG8_WAIT_L(0); PG8_BAR; PG8_MMA(0, 0, At, B0); PG8_MMA(0, 1, At, B1); PG8_BAR; PG8_SCHED;
            PG8_LDA(At, 0, 1); PG8_STAGE(PG8_SB(0, 0), b2, voffB); PG8_STAGE(PG8_SB(0, 1), b2 + hstepB, voffB); PG8_STAGE(PG8_SA(0, 0), a2, voffA);
            PG8_WAIT_V(8); PG8_WAIT_L(0); PG8_BAR; PG8_MMA(1, 0, At, B0); PG8_MMA(1, 1, At, B1); PG8_BAR; PG8_SCHED;
            PG8_LDB(B0, 1, 0); PG8_LDB(B1, 1, 1); PG8_SCHED; PG8_LDA(At, 1, 0); PG8_STAGE(PG8_SA(0, 1), a2 + hstepA, voffA);
            PG8_WAIT_V(8); PG8_WAIT_L(0); PG8_BAR; PG8_MMA(0, 0, At, B0); PG8_MMA(0, 1, At, B1); PG8_BAR; PG8_SCHED;
            PG8_LDA(At, 1, 1); PG8_STAGE(PG8_SB(1, 0), b3, voffB); PG8_STAGE(PG8_SB(1, 1), b3 + hstepB, voffB); PG8_STAGE(PG8_SA(1, 0), a3, voffA);
            PG8_WAIT_V(8); PG8_WAIT_L(0); PG8_BAR; PG8_MMA(1, 0, At, B0); PG8_MMA(1, 1, At, B1); PG8_BAR; PG8_SCHED;
        }
        if constexpr (ALIGN_EPI) { if (wr == 0) PG8_BAR; }
        { int fr_ = fr, fq_ = fq; asm volatile("" : "+v"(fr_), "+v"(fq_));
          E(acc, cur, wr, wc, fr_, fq_); }
        if (!has_next) break;
#pragma unroll
        for (int a = 0; a < 2; ++a)
#pragma unroll
            for (int b = 0; b < 2; ++b)
#pragma unroll
                for (int m = 0; m < 4; ++m)
#pragma unroll
                    for (int n = 0; n < 2; ++n) acc[a][b][m][n] = (f32x4){0.f, 0.f, 0.f, 0.f};
        cur = nxt; cA = nA; cB = nB; ++ui;
        if constexpr (ALIGN_EPI) { if (wr == 1) PG8_BAR; }
    }
    PG8_WAIT_V(0);
    if constexpr (!ALIGN_EPI) { if (wr == 0) PG8_BAR; }
    PG8_BAR;
#undef PG8_SA
#undef PG8_SB
#undef PG8_STAGE
#undef PG8_LDA
#undef PG8_LDB
#undef PG8_MMA
#undef PG8_WAIT_V
#undef PG8_WAIT_L
#undef PG8_BAR
#undef PG8_SCHED
}
}

constexpr int NWAVES = 8;
constexpr int N_LAUNCHES = MK_N_LAUNCHES;
constexpr int PER_PHASE = 11;
constexpr int NB = 4, SEQ = 2048, DM = 2048, M = NB * SEQ;
constexpr int DL = 1024, DR = 1024, NH = 16, HD = 64;
constexpr int INW = 5408, INWP = 5632;
constexpr int PROJW = 3360;
constexpr int DFF = 5632, NMODC = 6 * DM;
constexpr int LK = 384;
constexpr int NSEG = M / 64;

constexpr size_t MiB = 1u << 20;
constexpr size_t WS_CTL = 0, CTL_ZERO_BYTES = 64 * 1024;
constexpr size_t WS_MODP = 1 * MiB;
constexpr size_t WS_MOD = 2 * MiB;
constexpr size_t WS_LRUW = 3 * MiB;
constexpr size_t WS_LORAW = 4 * MiB;
constexpr size_t WS_SEG = 7 * MiB;
constexpr size_t WS_WIN = 8 * MiB;
constexpr size_t WS_WOUT = 30 * MiB;
constexpr size_t WS_WGU = 38 * MiB;
constexpr size_t WS_WDN = 82 * MiB;
constexpr size_t WS_H = 104 * MiB;
constexpr size_t WS_U = 104 * MiB;
constexpr size_t WS_AL = 120 * MiB;
constexpr size_t WS_P = 136 * MiB;
constexpr size_t WS_DEC = 224 * MiB;
constexpr size_t WS_AA = 256 * MiB;
constexpr size_t WS_GG = 288 * MiB;
constexpr size_t WS_HLOC = 304 * MiB;
constexpr size_t WS_PCUM = 320 * MiB;
constexpr size_t WS_MIX = 336 * MiB;
constexpr size_t WS_END = 368 * MiB;
constexpr int CW_BAR = 1024;

constexpr int RING_OFF = 0, RING_BYTES = 131072;
constexpr int LDSCTL_OFF = RING_BYTES, MISC_OFF = LDSCTL_OFF + 320;
constexpr int LDS_BYTES = 147456;

#define GAS __attribute__((address_space(1)))
#define LAS __attribute__((address_space(3)))
typedef unsigned short bf16;
typedef unsigned v4u __attribute__((ext_vector_type(4)));
typedef unsigned v2u __attribute__((ext_vector_type(2)));
typedef float f32x4 __attribute__((ext_vector_type(4)));
typedef float f32x2 __attribute__((ext_vector_type(2)));
typedef GAS unsigned gu32;
#define RLX_AGENT __ATOMIC_RELAXED, __HIP_MEMORY_SCOPE_AGENT
#define LDS_WAIT() asm volatile("s_waitcnt lgkmcnt(0)" ::: "memory")
__device__ __forceinline__ unsigned f2bf(float f) { unsigned u = __builtin_bit_cast(unsigned, f); return (u + 0x7fffu + ((u >> 16) & 1u)) >> 16; }
__device__ __forceinline__ unsigned pk2(float lo, float hi) { return f2bf(lo) | (f2bf(hi) << 16); }
__device__ __forceinline__ float bflo(unsigned w) { return __uint_as_float(w << 16); }
__device__ __forceinline__ float bfhi(unsigned w) { return __uint_as_float(w & 0xffff0000u); }

#define XB_TMO      128
#define XB_XCNT(j)  (256  + 64 * (j))
#define XB_XSUB(j)  (1280 + 64 * (j))
#define XB_XGEN(j)  (2304 + 64 * (j))
#define XB_TOP      3328
#define XB_TOPGEN   3392
#define XCD_BAR_WORDS 3456
#define XB_SPIN_CAP (1u << 20)
__device__ __forceinline__ unsigned xb_ld(unsigned* p)              { return __hip_atomic_load(p, __ATOMIC_RELAXED, __HIP_MEMORY_SCOPE_AGENT); }
__device__ __forceinline__ unsigned xb_add(unsigned* p, unsigned v) { return __hip_atomic_fetch_add(p, v, __ATOMIC_RELAXED, __HIP_MEMORY_SCOPE_AGENT); }
__device__ __forceinline__ unsigned xb_xcc_id() { return (unsigned)__builtin_amdgcn_s_getreg((3 << 11) | 20) & 0xFu; }
#define XB_SPIN(cond, bar) do { unsigned _sp = 0; while (cond) { __builtin_amdgcn_s_sleep(1); \
    if ((++_sp & 255u) == 0u) { if (xb_ld(&(bar)[XB_TMO])) break; if (_sp > XB_SPIN_CAP) { atomicAdd(&(bar)[XB_TMO], 1u); break; } } } } while (0)
struct XcdBarrier { unsigned* bar; unsigned x; volatile LAS unsigned* st; };
__device__ __forceinline__ XcdBarrier xcd_barrier_post(unsigned* bar, volatile LAS unsigned* st) {
    XcdBarrier b; b.bar = bar; b.x = xb_xcc_id(); b.st = st;
    if (threadIdx.x == 0) (void)xb_add(&bar[XB_XCNT(b.x)], 1u);
    return b;
}
__device__ __forceinline__ void xcd_barrier_complete(unsigned* bar, unsigned x, unsigned& nloc, unsigned& nx) {
    const unsigned G = gridDim.x * gridDim.y * gridDim.z;
    unsigned sum, cnt, mine, sp = 0u;
    for (;;) {
        sum = 0u; cnt = 0u; mine = 0u;
#pragma unroll
        for (unsigned j = 0; j < 16; ++j) { const unsigned c = xb_ld(&bar[XB_XCNT(j)]); sum += c; cnt += (c > 0u) ? 1u : 0u; mine = (j == x) ? c : mine; }
        if (sum == G) break;
        __builtin_amdgcn_s_sleep(1);
        if ((++sp & 255u) == 0u) { if (xb_ld(&bar[XB_TMO])) break; if (sp > XB_SPIN_CAP) { atomicAdd(&bar[XB_TMO], 1u); break; } }
    }
    nloc = mine > 0u ? mine : 1u; nx = cnt > 0u ? cnt : 1u;
}
__device__ __forceinline__ void xcd_barrier(const XcdBarrier& b) {
    asm volatile("s_waitcnt vmcnt(0)" ::: "memory");
    __syncthreads();
    if (threadIdx.x == 0) {
        unsigned* bar = b.bar;
        __builtin_amdgcn_s_waitcnt(0);
        unsigned nloc = b.st[0], nx = b.st[1];
        if (nloc == 0u) { xcd_barrier_complete(bar, b.x, nloc, nx); b.st[0] = nloc; b.st[1] = nx; }
        const unsigned old = xb_add(&bar[XB_XSUB(b.x)], 1u);
        const unsigned gen = old / nloc;
        if (old + 1u == (gen + 1u) * nloc) {
            __builtin_amdgcn_fence(__ATOMIC_RELEASE, "agent");
            asm volatile("s_waitcnt vmcnt(0)" ::: "memory");
            const unsigned og = xb_add(&bar[XB_TOP], 1u);
            const unsigned tg = og / nx;
            if (og + 1u == (tg + 1u) * nx) xb_add(&bar[XB_TOPGEN], 1u);
            else XB_SPIN(xb_ld(&bar[XB_TOPGEN]) == tg, bar);
            __builtin_amdgcn_fence(__ATOMIC_ACQUIRE, "agent");
            xb_add(&bar[XB_XGEN(b.x)], 1u);
            asm volatile("s_waitcnt vmcnt(0)" ::: "memory");
        } else {
            XB_SPIN(xb_ld(&bar[XB_XGEN(b.x)]) == gen, bar);
            __builtin_amdgcn_fence(__ATOMIC_ACQUIRE, "agent");
            asm volatile("s_waitcnt vmcnt(0)" ::: "memory");
        }
    }
    __syncthreads();
}

struct Frame {
    LAS unsigned char* lds;
    int tid, lane, wave;
    int vcu, G;
};
struct Args { const float* in[29]; float* out; unsigned char* ws; int ph_lo, ph_hi; };

__device__ __forceinline__ float wave_sum(float v) {
#pragma unroll
    for (int o = 1; o < 64; o <<= 1) v += __shfl_xor(v, o);
    return v;
}
__device__ __forceinline__ void transpose_item(const float* W, int N, bf16* WT, int ldk, int k0, int n0, int drow0, LAS float* scr, int lane) {
#pragma unroll 8
    for (int i = 0; i < 32; ++i) { const int kk = 2 * i + (lane >> 5); scr[kk * 33 + (lane & 31)] = W[(size_t)(k0 + kk) * N + n0 + (lane & 31)]; }
    LDS_WAIT(); asm volatile("" ::: "memory");
    const int c = lane & 7;
#pragma unroll
    for (int j = 0; j < 4; ++j) { const int n = (lane >> 3) + 8 * j; const LAS float* s = scr + (8 * c) * 33 + n;
        v4u o; o.x = pk2(s[0 * 33], s[1 * 33]); o.y = pk2(s[2 * 33], s[3 * 33]); o.z = pk2(s[4 * 33], s[5 * 33]); o.w = pk2(s[6 * 33], s[7 * 33]);
        *(GAS v4u*)(WT + (size_t)(drow0 + n) * ldk + k0 + 8 * c) = o; }
    LDS_WAIT(); asm volatile("" ::: "memory");
}

constexpr int I_WIN = (DM / 64) * (INW / 32);
constexpr int I_WOUT = (DM / 64) * (DM / 32);
constexpr int I_LRU = 8 * 4 * 8;
constexpr int I_ZERO = INWP - INW;
constexpr int P0_ITEMS = I_WIN + I_WOUT + I_LRU + I_ZERO;
__device__ __forceinline__ void p0_item(const Args& a, int it, LAS float* scr, int lane) {
    unsigned char* ws = a.ws;
    if (it < I_WIN) { const int nblk = INW / 32, kb = it / nblk, nb = it % nblk; transpose_item(a.in[5], INW, (bf16*)(ws + WS_WIN), DM, 64 * kb, 32 * nb, 32 * nb, scr, lane); return; } it -= I_WIN;
    if (it < I_WOUT) { const int nblk = DM / 32, kb = it / nblk, nb = it % nblk; transpose_item(a.in[24], DM, (bf16*)(ws + WS_WOUT), DM, 64 * kb, 32 * nb, 32 * nb, scr, lane); return; } it -= I_WOUT;
    if (it < I_LRU) { const int hm = it >> 5, h = hm >> 1, mat = hm & 1, kb = (it >> 3) & 3, nb = it & 7, n0 = 32 * nb;
        const float* W = (mat ? a.in[10] : a.in[8]) + (size_t)h * 256 * 256;
        transpose_item(W, 256, (bf16*)(ws + WS_LRUW), 256, 64 * kb, n0, h * 512 + 256 * (n0 >> 7) + 128 * mat + (n0 & 127), scr, lane); return; } it -= I_LRU;
    { GAS v4u* o = (GAS v4u*)((bf16*)(ws + WS_WIN) + (size_t)(INW + it) * DM) + lane;
#pragma unroll
      for (int j = 0; j < 4; ++j) o[64 * j] = (v4u){0u, 0u, 0u, 0u}; }
}
__device__ __forceinline__ void p0_prologue(const Args& a, Frame& F) {
    const int wg = blockIdx.x;
    LAS float* scr = (LAS float*)(F.lds + RING_OFF + F.wave * 16384);
    if (wg < 192) {
        const int slab = wg % 48, ks = wg / 48, k0 = ks * 512 + F.wave * 64;
        const float* cin = a.in[1];
        float ca[4];
#pragma unroll
        for (int b = 0; b < 4; ++b) { const float c = cin[b * DM + k0 + F.lane]; ca[b] = c / (1.0f + __expf(-c)); }
        f32x4 acc[4];
#pragma unroll
        for (int b = 0; b < 4; ++b) acc[b] = (f32x4){0.f, 0.f, 0.f, 0.f};
        const GAS f32x4* wp = (const GAS f32x4*)(a.in[2] + (size_t)k0 * NMODC + slab * 256) + F.lane;
#pragma unroll 16
        for (int i = 0; i < 64; ++i) { const f32x4 w = wp[(size_t)i * (NMODC / 4)];
#pragma unroll
            for (int b = 0; b < 4; ++b) { const float s = __shfl(ca[b], i); acc[b] += w * s; } }
        LAS f32x4* red = (LAS f32x4*)(F.lds + RING_OFF);
#pragma unroll
        for (int b = 0; b < 4; ++b) red[(F.wave * 4 + b) * 64 + F.lane] = acc[b];
        __syncthreads();
        if (F.tid < 256) { const int b = F.tid >> 6, l = F.tid & 63; f32x4 s = red[(0 * 4 + b) * 64 + l];
#pragma unroll
            for (int w = 1; w < 8; ++w) s += red[(w * 4 + b) * 64 + l];
            *(GAS f32x4*)((float*)(a.ws + WS_MODP) + ((size_t)(ks * 4 + b) * NMODC + slab * 256 + l * 4)) = s; }
        __syncthreads();
    }
    if (wg >= 192) { for (int it = (wg - 192) * 8 + F.wave; it < 4096; it += 512) p0_item(a, it, scr, F.lane); }
    else { for (int it = 4096 + wg * 8 + F.wave; it < P0_ITEMS; it += 1536) p0_item(a, it, scr, F.lane); }
    { const int gt = wg * 512 + F.tid;
      for (int idx = gt; idx < 3 * 48 * 1024; idx += 256 * 512) { const int nn = idx & 1023, kc = (idx >> 10) % 48, blk = idx / (48 * 1024);
        const float* W = blk == 0 ? a.in[15] : (blk == 1 ? a.in[17] : a.in[18]);
        const int klo = blk == 0 ? 0 : (blk == 1 ? 64 : 128), khi = blk == 0 ? 64 : (blk == 1 ? 128 : 288);
        float v[8];
#pragma unroll
        for (int j = 0; j < 8; ++j) { const int k = 8 * kc + j; v[j] = (k >= klo && k < khi) ? W[(size_t)(k - klo) * 1024 + nn] : 0.f; }
        v4u o; o.x = pk2(v[0], v[1]); o.y = pk2(v[2], v[3]); o.z = pk2(v[4], v[5]); o.w = pk2(v[6], v[7]);
        *(GAS v4u*)((bf16*)(a.ws + WS_LORAW) + (size_t)(blk * 1024 + nn) * LK + 8 * kc) = o; } }
}

template <int MODE>
__device__ __forceinline__ void norm_phase(const Args& a, Frame& F) {
    LAS float* G1 = (LAS float*)(F.lds + RING_OFF);
    LAS float* S1 = G1 + DM;
    const int row0 = F.vcu * 32, b = row0 / SEQ;
    const float* gain = MODE == 0 ? a.in[4] : (MODE == 1 ? a.in[25] : a.in[28]);
    const float* modp = (const float*)(a.ws + WS_MODP); const float* mod = (const float*)(a.ws + WS_MOD); const float* bada = a.in[3];
    for (int k = F.tid; k < DM; k += 512) {
        float sh = 0.f, sc = 0.f;
        if (MODE == 0) { sh = bada[k]; sc = bada[DM + k];
#pragma unroll
            for (int ks = 0; ks < 4; ++ks) { sh += modp[(size_t)(ks * 4 + b) * NMODC + k]; sc += modp[(size_t)(ks * 4 + b) * NMODC + DM + k]; } }
        else if (MODE == 1) { sh = mod[(size_t)b * NMODC + 3 * DM + k]; sc = mod[(size_t)b * NMODC + 4 * DM + k]; }
        G1[k] = gain[k] * (1.0f + sc); S1[k] = sh;
    }
    if (MODE == 0 && F.tid < 192) { const int idx = blockIdx.x * 192 + F.tid, bb = idx / NMODC, j = idx % NMODC; float s = bada[j];
#pragma unroll
        for (int ks = 0; ks < 4; ++ks) s += modp[(size_t)(ks * 4 + bb) * NMODC + j];
        ((float*)(a.ws + WS_MOD))[idx] = s; }
    __syncthreads();
    const float* src = MODE == 0 ? a.in[0] : a.out;
    for (int rr = F.wave; rr < 32; rr += NWAVES) {
        const int row = row0 + rr;
        const GAS f32x4* xr = (const GAS f32x4*)(src + (size_t)row * DM) + F.lane;
        f32x4 v[8]; float s = 0.f;
#pragma unroll
        for (int j = 0; j < 8; ++j) { v[j] = xr[64 * j]; s += (v[j].x * v[j].x + v[j].y * v[j].y) + (v[j].z * v[j].z + v[j].w * v[j].w); }
        const float rstd = 1.0f / sqrtf(wave_sum(s) * (1.0f / DM) + 1e-6f);
        if (MODE == 2) { GAS f32x4* o = (GAS f32x4*)(a.out + (size_t)row * DM) + F.lane;
#pragma unroll
            for (int j = 0; j < 8; ++j) { const f32x4 g = *(LAS f32x4*)(G1 + 256 * j + 4 * F.lane); o[64 * j] = v[j] * rstd * g; } }
        else { GAS v2u* o = (GAS v2u*)((bf16*)(a.ws + WS_H) + (size_t)row * DM) + F.lane;
#pragma unroll
            for (int j = 0; j < 8; ++j) { const f32x4 g = *(LAS f32x4*)(G1 + 256 * j + 4 * F.lane), sh = *(LAS f32x4*)(S1 + 256 * j + 4 * F.lane);
                const f32x4 y = v[j] * rstd * g + sh; v2u w; w.x = pk2(y.x, y.y); w.y = pk2(y.z, y.w); o[64 * j] = w; } }
    }
    __syncthreads();
}

__device__ __forceinline__ void prep_phase(const Args& a, Frame& F) {
    const bf16* P = (const bf16*)(a.ws + WS_P); bf16* U = (bf16*)(a.ws + WS_U); bf16* AL = (bf16*)(a.ws + WS_AL);
    const int row0 = F.vcu * 32, tb0 = row0 & (SEQ - 1), c = 2 * F.tid;
    const float* cw = a.in[6]; const float* cb = a.in[7]; const float* mu = a.in[13];
    float w[4][2], bb[2];
#pragma unroll
    for (int k = 0; k < 4; ++k) { w[k][0] = cw[k * DL + c]; w[k][1] = cw[k * DL + c + 1]; }
    bb[0] = cb[c]; bb[1] = cb[c + 1];
    const bool lor = F.tid < LK / 2; const int j = 2 * F.tid;
    float m0 = 0.f, m1 = 0.f; if (lor && j < 288) { m0 = mu[3072 + j]; m1 = mu[3072 + j + 1]; }
    unsigned p3 = 0u, p2 = 0u, p1 = 0u, lp = 0u;
    if (tb0 != 0) { p3 = *(const GAS unsigned*)(P + (size_t)(row0 - 3) * INWP + c); p2 = *(const GAS unsigned*)(P + (size_t)(row0 - 2) * INWP + c); p1 = *(const GAS unsigned*)(P + (size_t)(row0 - 1) * INWP + c);
        if (lor && j < 288) lp = *(const GAS unsigned*)(P + (size_t)(row0 - 1) * INWP + 5120 + j); }
    for (int rr = 0; rr < 32; ++rr) { const int t = row0 + rr;
        const unsigned p0 = *(const GAS unsigned*)(P + (size_t)t * INWP + c);
        const float u0 = bb[0] + w[0][0] * bflo(p3) + w[1][0] * bflo(p2) + w[2][0] * bflo(p1) + w[3][0] * bflo(p0);
        const float u1 = bb[1] + w[0][1] * bfhi(p3) + w[1][1] * bfhi(p2) + w[2][1] * bfhi(p1) + w[3][1] * bfhi(p0);
        *(GAS unsigned*)(U + (size_t)t * DL + c) = pk2(u0, u1);
        p3 = p2; p2 = p1; p1 = p0;
        if (lor) { float o0 = 0.f, o1 = 0.f;
            if (j < 288) { const unsigned q = *(const GAS unsigned*)(P + (size_t)t * INWP + 5120 + j);
                const float x0 = bflo(q) + (bflo(lp) - bflo(q)) * m0, x1 = bfhi(q) + (bfhi(lp) - bfhi(q)) * m1; lp = q;
                if (j < 64) { o0 = 1.0f - 2.0f * __builtin_amdgcn_rcpf(1.0f + __builtin_amdgcn_exp2f(2.88539008178f * x0)); o1 = 1.0f - 2.0f * __builtin_amdgcn_rcpf(1.0f + __builtin_amdgcn_exp2f(2.88539008178f * x1)); }
                else if (j < 128) { o0 = x0; o1 = x1; }
                else { o0 = pg8::fast_sigmoid(x0); o1 = pg8::fast_sigmoid(x1); } }
            *(GAS unsigned*)(AL + (size_t)t * LK + j) = pk2(o0, o1); }
    }
}

constexpr int TC = 32;
constexpr int CH_F = TC * 6 * 64;
__device__ __forceinline__ float dpp_x1(float x) { return __int_as_float(__builtin_amdgcn_update_dpp(0, __float_as_int(x), 0xB1, 0xf, 0xf, true)); }
__device__ __forceinline__ float dpp_x2(float x) { return __int_as_float(__builtin_amdgcn_update_dpp(0, __float_as_int(x), 0x4E, 0xf, 0xf, true)); }
__device__ __forceinline__ float dpp_hm(float x) { return __int_as_float(__builtin_amdgcn_update_dpp(0, __float_as_int(x), 0x141, 0xf, 0xf, true)); }
__device__ __forceinline__ float dpp_rm(float x) { return __int_as_float(__builtin_amdgcn_update_dpp(0, __float_as_int(x), 0x140, 0xf, 0xf, true)); }
__device__ __forceinline__ float red8(float x) { x += dpp_x1(x); x += dpp_x2(x); x += dpp_hm(x); return x; }
__device__ __forceinline__ float red16(float x) { x = red8(x); x += dpp_rm(x); return x; }

struct RwkvLoad { v2u pr, pk, pv, qr, qk, qv; f32x4 aa, dd; };
__device__ __forceinline__ void rwkv_issue(const Args& a, int bh, int chunk, int tid, RwkvLoad& L) {
    const int b = bh >> 4, hd = bh & 15, tt = tid >> 4, jq = tid & 15, tl = chunk * TC + tt, t = b * SEQ + tl, cc = hd * 64 + 4 * jq;
    const bf16* P = (const bf16*)(a.ws + WS_P) + (size_t)t * INWP + 2048 + cc;
    L.pr = *(const GAS v2u*)(P); L.pk = *(const GAS v2u*)(P + 1024); L.pv = *(const GAS v2u*)(P + 2048);
    if (tl > 0) { L.qr = *(const GAS v2u*)(P - INWP); L.qk = *(const GAS v2u*)(P - INWP + 1024); L.qv = *(const GAS v2u*)(P - INWP + 2048); }
    else { L.qr = (v2u){0u, 0u}; L.qk = (v2u){0u, 0u}; L.qv = (v2u){0u, 0u}; }
    L.aa = *(const GAS f32x4*)((const float*)(a.ws + WS_AA) + (size_t)t * DR + cc);
    L.dd = *(const GAS f32x4*)((const float*)(a.ws + WS_DEC) + (size_t)t * DR + cc);
}
__device__ __forceinline__ f32x4 unpack4(v2u w) { return (f32x4){bflo(w.x), bfhi(w.x), bflo(w.y), bfhi(w.y)}; }

__device__ __forceinline__ void rwkv_phase(const Args& a, Frame& F) {
    const int bh = blockIdx.x, b = bh >> 4, hd = bh & 15, tid = F.tid;
    LAS float* buf = (LAS float*)(F.lds + RING_OFF);
    LAS float* YB = buf + 2 * CH_F;
    LAS float* RK = YB + TC * 64;
    const int tt = tid >> 4, jq = tid & 15, cc = hd * 64 + 4 * jq;
    const f32x4 mur = *(const GAS f32x4*)(a.in[13] + cc), muk = *(const GAS f32x4*)(a.in[13] + 1024 + cc), muv = *(const GAS f32x4*)(a.in[13] + 2048 + cc);
    const f32x4 kkw = *(const GAS f32x4*)(a.in[19] + cc), kaw = *(const GAS f32x4*)(a.in[20] + cc), rkw = *(const GAS f32x4*)(a.in[21] + cc);
    const f32x4 lng = *(const GAS f32x4*)(a.in[22] + cc), lnb = *(const GAS f32x4*)(a.in[23] + cc);
    const int v = tid >> 3, kq = tid & 7;
    float st[8];
#pragma unroll
    for (int j = 0; j < 8; ++j) st[j] = 0.f;
    RwkvLoad L;
    rwkv_issue(a, bh, 0, tid, L);
    constexpr int NCH = SEQ / TC;
    for (int ch = 0; ch <= NCH; ++ch) {
        if (ch < NCH) {
            LAS float* B = buf + (ch & 1) * CH_F + tt * 384 + 4 * jq;
            const f32x4 pr = unpack4(L.pr), pk = unpack4(L.pk), pv = unpack4(L.pv), qr = unpack4(L.qr), qk = unpack4(L.qk), qv = unpack4(L.qv);
            const f32x4 xr = pr + (qr - pr) * mur, xk = pk + (qk - pk) * muk, xv = pv + (qv - pv) * muv;
            const f32x4 kr = xk * kkw;
            const float ss = red16((kr.x * kr.x + kr.y * kr.y) + (kr.z * kr.z + kr.w * kr.w));
            const float inv = 1.0f / fmaxf(sqrtf(ss), 1e-12f);
            const f32x4 kk = kr * inv;
            const f32x4 km = xk * (1.0f + (L.aa - 1.0f) * kaw);
            const f32x4 rkp = xr * km * rkw;
            const float rk = red16((rkp.x + rkp.y) + (rkp.z + rkp.w));
            *(LAS f32x4*)(B) = xr; *(LAS f32x4*)(B + 64) = L.dd; *(LAS f32x4*)(B + 128) = km; *(LAS f32x4*)(B + 192) = -kk; *(LAS f32x4*)(B + 256) = kk * L.aa; *(LAS f32x4*)(B + 320) = xv;
            if (jq == 0) RK[(ch & 1) * TC + tt] = rk;
        }
        __syncthreads();
        if (ch > 0) { const int pc = ch - 1, t = b * SEQ + pc * TC + tt;
            const f32x4 y = *(LAS f32x4*)(YB + tt * 64 + 4 * jq);
            const float mean = red16((y.x + y.y) + (y.z + y.w)) * (1.0f / 64.0f);
            const f32x4 dy = y - mean;
            const float var = red16((dy.x * dy.x + dy.y * dy.y) + (dy.z * dy.z + dy.w * dy.w)) * (1.0f / 64.0f);
            const float rs = 1.0f / sqrtf(var + 64e-5f);
            const f32x4 vv = *(LAS f32x4*)(buf + (pc & 1) * CH_F + tt * 384 + 320 + 4 * jq);
            const float rk = RK[(pc & 1) * TC + tt];
            const f32x4 g = unpack4(*(const GAS v2u*)((const bf16*)(a.ws + WS_GG) + (size_t)t * DR + cc));
            const f32x4 o = (dy * rs * lng + lnb + vv * rk) * g;
            v2u w; w.x = pk2(o.x, o.y); w.y = pk2(o.z, o.w);
            *(GAS v2u*)((bf16*)(a.ws + WS_MIX) + (size_t)t * DM + DL + cc) = w; }
        if (ch == NCH) break;
        if (ch + 1 < NCH) rwkv_issue(a, bh, ch + 1, tid, L);
        __syncthreads();
        const LAS float* B = buf + (ch & 1) * CH_F + 8 * kq;
#pragma unroll 4
        for (int s = 0; s < TC; ++s) { const LAS float* q = B + s * 384;
            const f32x4 r0 = *(const LAS f32x4*)(q), r1 = *(const LAS f32x4*)(q + 4), d0 = *(const LAS f32x4*)(q + 64), d1 = *(const LAS f32x4*)(q + 68);
            const f32x4 k0 = *(const LAS f32x4*)(q + 128), k1 = *(const LAS f32x4*)(q + 132), a0 = *(const LAS f32x4*)(q + 192), a1 = *(const LAS f32x4*)(q + 196);
            const f32x4 b0 = *(const LAS f32x4*)(q + 256), b1 = *(const LAS f32x4*)(q + 260);
            const float vv = q[320 - 8 * kq + v];
            float sa = (st[0] * a0.x + st[1] * a0.y) + (st[2] * a0.z + st[3] * a0.w) + (st[4] * a1.x + st[5] * a1.y) + (st[6] * a1.z + st[7] * a1.w);
            sa = red8(sa);
            st[0] = st[0] * d0.x + (sa * b0.x + vv * k0.x); st[1] = st[1] * d0.y + (sa * b0.y + vv * k0.y); st[2] = st[2] * d0.z + (sa * b0.z + vv * k0.z); st[3] = st[3] * d0.w + (sa * b0.w + vv * k0.w);
            st[4] = st[4] * d1.x + (sa * b1.x + vv * k1.x); st[5] = st[5] * d1.y + (sa * b1.y + vv * k1.y); st[6] = st[6] * d1.z + (sa * b1.z + vv * k1.z); st[7] = st[7] * d1.w + (sa * b1.w + vv * k1.w);
            float y = (st[0] * r0.x + st[1] * r0.y) + (st[2] * r0.z + st[3] * r0.w) + (st[4] * r1.x + st[5] * r1.y) + (st[6] * r1.z + st[7] * r1.w);
            y = red8(y);
            if (kq == 0) YB[s * 64 + v] = y;
        }
    }
    __syncthreads();
}

constexpr int I_WGU = (DM / 64) * (2 * DFF / 32);
constexpr int I_WDN = (DFF / 64) * (DM / 32);
__device__ __forceinline__ void p5_other(const Args& a, Frame& F) {
    const int ow = blockIdx.x - 64;
    unsigned char* ws = a.ws;
    if (ow < NSEG) { const int s = ow, sb = s & ~31, cq = F.tid & 255, rp = F.tid >> 8;
        const float* PS = (const float*)(ws + WS_SEG); const float* HS = PS + (size_t)NSEG * DL;
        f32x4 carry = (f32x4){0.f, 0.f, 0.f, 0.f};
        for (int s2 = sb; s2 < s; ++s2) { const f32x4 p = *(const GAS f32x4*)(PS + (size_t)s2 * DL + 4 * cq), h = *(const GAS f32x4*)(HS + (size_t)s2 * DL + 4 * cq); carry = p * carry + h; }
        for (int r = rp; r < 64; r += 2) { const size_t t = (size_t)s * 64 + r;
            const f32x4 hl = unpack4(*(const GAS v2u*)((const bf16*)(ws + WS_HLOC) + t * DL + 4 * cq)), pc = unpack4(*(const GAS v2u*)((const bf16*)(ws + WS_PCUM) + t * DL + 4 * cq));
            const f32x4 gt = unpack4(*(const GAS v2u*)((const bf16*)(ws + WS_P) + t * INWP + DL + 4 * cq));
            const f32x4 o = (hl + pc * carry) * gt; v2u w; w.x = pk2(o.x, o.y); w.y = pk2(o.z, o.w);
            *(GAS v2u*)((bf16*)(ws + WS_MIX) + t * DM + 4 * cq) = w; } }
    LAS float* scr = (LAS float*)(F.lds + RING_OFF + F.wave * 16384);
    for (int it = ow * 8 + F.wave; it < I_WGU + I_WDN; it += 192 * 8) {
        if (it < I_WGU) { const int nblk = 2 * DFF / 32, kb = it / nblk, nb = it % nblk, n0 = 32 * nb, mat = n0 >= DFF ? 1 : 0, f0 = n0 - mat * DFF;
            transpose_item(a.in[26], 2 * DFF, (bf16*)(ws + WS_WGU), DM, 64 * kb, n0, 256 * (f0 >> 7) + 128 * mat + (f0 & 127), scr, F.lane); }
        else { const int i2 = it - I_WGU, nblk = DM / 32, kb = i2 / nblk, nb = i2 % nblk; transpose_item(a.in[27], DM, (bf16*)(ws + WS_WDN), DFF, 64 * kb, 32 * nb, 32 * nb, scr, F.lane); }
    }
}

__global__ void __launch_bounds__(NWAVES * 64, 2) hybrid_fwd(Args args) {
    extern __shared__ __attribute__((aligned(16))) unsigned char lds[];
    Frame F;
    F.lds = (LAS unsigned char*)lds;
    F.tid = threadIdx.x; F.lane = F.tid & 63; F.wave = __builtin_amdgcn_readfirstlane(F.tid >> 6);
    F.G = gridDim.x; { const int bx = blockIdx.x; F.vcu = (bx % 8) * (F.G / 8) + bx / 8; }
    unsigned char* ws = args.ws;
    gu32* ctl = (gu32*)(ws + WS_CTL);
    for (int u = F.tid; u < (LDS_BYTES - LDSCTL_OFF) / 4; u += NWAVES * 64) ((LAS unsigned*)(F.lds + LDSCTL_OFF))[u] = 0u;
    __syncthreads();
    XcdBarrier bar; bar.bar = (unsigned*)(ctl + CW_BAR); bar.x = 0; bar.st = nullptr;
    if (N_LAUNCHES == 1) bar = xcd_barrier_post((unsigned*)(ctl + CW_BAR), (volatile LAS unsigned*)(F.lds + MISC_OFF) + 8);
    const int lo = args.ph_lo, hi = args.ph_hi;
#define IN(k) (lo <= (k) && (k) < hi)
#define SEAM(k) do { if (IN(k) && IN((k) + 1)) xcd_barrier(bar); } while (0)
    typedef pg8::bf16_t b16;

    if (IN(0)) { p0_prologue(args, F); } SEAM(0);
    if (IN(1)) { norm_phase<0>(args, F); } SEAM(1);
    if (IN(2)) {
        pg8::Gemm g{(const b16*)(ws + WS_H), (const b16*)(ws + WS_WIN), DM, DM, DM, 0, 0}; pg8::StaticOrder S; S.init(M, INWP, F.G, (int)blockIdx.x);
        pg8::EpiP E{(b16*)(ws + WS_P), INWP};
        pg8::gemm_phase<pg8::EpiP, pg8::StaticOrder, true>(F.lds + RING_OFF, g, S, E);
    } SEAM(2);
    if (IN(3)) { prep_phase(args, F); } SEAM(3);
    if (IN(4)) {
        { pg8::Gemm g{(const b16*)(ws + WS_U), (const b16*)(ws + WS_LRUW), DL, 256, 256, 256, 512 * 256}; pg8::LruOrder S{F.G, (int)blockIdx.x};
          pg8::EpiLru E{(const b16*)(ws + WS_U), args.in[9], args.in[11], args.in[12], (b16*)(ws + WS_HLOC), (b16*)(ws + WS_PCUM), (float*)(ws + WS_SEG), (float*)(ws + WS_SEG) + (size_t)NSEG * DL};
          pg8::gemm_phase<pg8::EpiLru, pg8::LruOrder, false>(F.lds + RING_OFF, g, S, E); }
        { pg8::Gemm g{(const b16*)(ws + WS_AL), (const b16*)(ws + WS_LORAW), LK, LK, LK, 0, 0}; pg8::StaticOrder S; S.init(M, 3072, F.G, (int)blockIdx.x);
          pg8::EpiLora E{(float*)(ws + WS_DEC), (float*)(ws + WS_AA), (b16*)(ws + WS_GG), args.in[14], args.in[16]};
          pg8::gemm_phase<pg8::EpiLora, pg8::StaticOrder, true>(F.lds + RING_OFF, g, S, E); }
    } SEAM(4);
    if (IN(5)) { if (blockIdx.x < 64) rwkv_phase(args, F); else p5_other(args, F); } SEAM(5);
    if (IN(6)) {
        pg8::Gemm g{(const b16*)(ws + WS_MIX), (const b16*)(ws + WS_WOUT), DM, DM, DM, 0, 0}; pg8::StaticOrder S; S.init(M, DM, F.G, (int)blockIdx.x);
        pg8::EpiRes E{args.in[0], args.out, (const float*)(ws + WS_MOD) + 2 * DM, DM, NMODC};
        pg8::gemm_phase<pg8::EpiRes, pg8::StaticOrder, false>(F.lds + RING_OFF, g, S, E);
    } SEAM(6);
    if (IN(7)) { norm_phase<1>(args, F); } SEAM(7);
    if (IN(8)) {
        pg8::Gemm g{(const b16*)(ws + WS_H), (const b16*)(ws + WS_WGU), DM, DM, DM, 0, 0}; pg8::StaticOrder S; S.init(M, 2 * DFF, F.G, (int)blockIdx.x);
        pg8::EpiSwiglu E{(b16*)(ws + WS_P), DFF};
        pg8::gemm_phase<pg8::EpiSwiglu, pg8::StaticOrder, true>(F.lds + RING_OFF, g, S, E);
    } SEAM(8);
    if (IN(9)) {
        pg8::Gemm g{(const b16*)(ws + WS_P), (const b16*)(ws + WS_WDN), DFF, DFF, DFF, 0, 0}; pg8::StaticOrder S; S.init(M, DM, F.G, (int)blockIdx.x);
        pg8::EpiRes E{args.out, args.out, (const float*)(ws + WS_MOD) + 5 * DM, DM, NMODC};
        pg8::gemm_phase<pg8::EpiRes, pg8::StaticOrder, false>(F.lds + RING_OFF, g, S, E);
    } SEAM(9);
    if (IN(10)) { norm_phase<2>(args, F); }
#undef IN
#undef SEAM
}

extern "C" void kernel_launch(void* const* d_in, const int* in_sizes, int n_in, void* d_out, int out_size, void* d_ws, size_t ws_size, hipStream_t stream) {
    static int grid = 0;
    if (grid == 0) {
        if (n_in != 29 || in_sizes[0] != M * DM || out_size != M * DM || ws_size < WS_END) {
            fprintf(stderr, "kernel_launch: unexpected shapes: n_in %d in0 %d out %d ws %zu (need %zu)\n", n_in, n_in > 0 ? in_sizes[0] : -1, out_size, ws_size, (size_t)WS_END); grid = -1; return; }
        int dev = 0, cus = 0, per_cu = 0;
        if (hipGetDevice(&dev) != hipSuccess || hipDeviceGetAttribute(&cus, hipDeviceAttributeMultiprocessorCount, dev) != hipSuccess) { grid = -1; return; }
        if (hipFuncSetAttribute((const void*)hybrid_fwd, hipFuncAttributeMaxDynamicSharedMemorySize, LDS_BYTES) != hipSuccess) { fprintf(stderr, "kernel_launch: hipFuncSetAttribute failed\n"); grid = -1; return; }
        if (hipOccupancyMaxActiveBlocksPerMultiprocessor(&per_cu, (const void*)hybrid_fwd, NWAVES * 64, LDS_BYTES) != hipSuccess || per_cu < 1) {
            fprintf(stderr, "kernel_launch: occupancy query reports %d workgroups per CU\n", per_cu); (void)hipGetLastError(); grid = -1; return; }
        grid = cus;
        if (grid != 256) { fprintf(stderr, "kernel_launch: built for a 256-CU device, found %d CUs\n", cus); grid = -1; return; }
    }
    if (grid < 0) return;
    (void)hipMemsetAsync((char*)d_ws + WS_CTL, 0, CTL_ZERO_BYTES, stream);
    Args a{};
    for (int i = 0; i < 29; ++i) a.in[i] = (const float*)d_in[i];
    a.out = (float*)d_out; a.ws = (unsigned char*)d_ws;
    if (N_LAUNCHES == 1) {
        a.ph_lo = 0; a.ph_hi = PER_PHASE;
        void* kargs[] = {&a};
        hipError_t e = hipLaunchCooperativeKernel((const void*)hybrid_fwd, dim3(grid), dim3(NWAVES * 64), kargs, LDS_BYTES, stream);
        if (e != hipSuccess) fprintf(stderr, "kernel_launch: cooperative launch failed: %s\n", hipGetErrorString(e));
    } else {
        for (int li = 0; li < PER_PHASE; ++li) { a.ph_lo = li; a.ph_hi = li + 1;
            hipLaunchKernelGGL(hybrid_fwd, dim3(grid), dim3(NWAVES * 64), LDS_BYTES, stream, a); }
    }
}
```

```cpp
#include <hip/hip_runtime.h>
#include <cstdio>
#include <cstdint>

#ifndef MK_N_LAUNCHES
#define MK_N_LAUNCHES 1
#endif
#ifndef PROBE_PHASE
#define PROBE_PHASE -1
#endif
#ifndef PROBE_REPS
#define PROBE_REPS 2
#endif

namespace pg8 {
#define PG8_LAS __attribute__((address_space(3)))
typedef unsigned short bf16_t;
typedef short bf16x8 __attribute__((ext_vector_type(8)));
typedef float f32x4 __attribute__((ext_vector_type(4)));
typedef float f32x2 __attribute__((ext_vector_type(2)));
typedef unsigned u32x4 __attribute__((ext_vector_type(4)));
typedef unsigned u32x2 __attribute__((ext_vector_type(2)));
constexpr int BM = 256, BK = 64, HALF = 128, HTB = HALF * BK * 2, STAGE_BYTES = 8 * HTB, NXCD = 8, WGM = 8;

__host__ __device__ __forceinline__ int lds_byte(int r, int c) { const int st = (r >> 4) * 2 + (c >> 5), rr = r & 15, cc = c & 31, ob = rr * 64 + cc * 2; return st * 1024 + (ob ^ (((ob >> 9) & 1) << 5)); }
__host__ __device__ __forceinline__ void stage_rc(int b, int& R, int& C) { const int st = b / 1024, sb = b % 1024, swz = sb ^ (((sb >> 9) & 1) << 5); R = (st >> 1) * 16 + swz / 64; C = (st & 1) * 32 + (swz % 64) / 2; }
__host__ __device__ __forceinline__ int perm32(int rho) { const int n = rho >> 4, i = rho & 15; return 8 * (i >> 2) + 4 * n + (i & 3); }

struct Unit { int pm, pn, z; };
struct Gemm { const bf16_t* A; const bf16_t* Bt; int lda, ldb, K; long zA, zB; };

struct StaticOrder {
    int nM, nN, nwg, G, c;
    __host__ __device__ void init(int M, int N, int G_, int c_) { nM = M / BM; nN = N / BM; nwg = nM * nN; G = G_; c = c_; }
    __host__ __device__ bool next(int i, Unit& u) const {
        const long L = (long)i * G + c; if (L >= nwg) return false;
        int wgid = (int)L; { const int q = nwg / NXCD, r = nwg % NXCD, xcd = wgid % NXCD, off = wgid / NXCD; wgid = (xcd < r ? xcd * (q + 1) : r * (q + 1) + (xcd - r) * q) + off; }
        const int nig = WGM * nN, gid = wgid / nig, fm = gid * WGM, gsz = (nM - fm) < WGM ? (nM - fm) : WGM;
        u.pm = fm + ((wgid % nig) % gsz); u.pn = (wgid % nig) / gsz; u.z = 0; return true;
    }
};
struct LruOrder {
    int G, c;
    __host__ __device__ bool next(int i, Unit& u) const { const int L = i * G + c; if (L >= 256) return false; u.z = L >> 6; u.pm = (L & 63) >> 1; u.pn = L & 1; return true; }
};

typedef __bf16 bf16x2_t __attribute__((ext_vector_type(2)));
__device__ __forceinline__ unsigned cvt_pk_bf16(float lo, float hi) { const f32x2 v = {lo, hi}; return __builtin_bit_cast(unsigned, __builtin_convertvector(v, bf16x2_t)); }
__device__ __forceinline__ float fast_sigmoid(float x) { return __builtin_amdgcn_rcpf(1.0f + __builtin_amdgcn_exp2f(-1.44269504089f * x)); }
__device__ __forceinline__ float gelu_tanh(float x) { const float t = x + 0.044715f * x * x * x; return x * __builtin_amdgcn_rcpf(1.0f + __builtin_amdgcn_exp2f(-2.30220819814f * t)); }
__device__ __forceinline__ float bf_lo(unsigned w) { return __uint_as_float(w << 16); }
__device__ __forceinline__ float bf_hi(unsigned w) { return __uint_as_float(w & 0xffff0000u); }

struct EpiP {
    static constexpr bool PERM = true;
    bf16_t* O; int ldc;
    __device__ __forceinline__ void operator()(f32x4 (&acc)[2][2][4][2], const Unit& u, int wr, int wc, int fr, int fq) const {
        const int row0 = u.pm * BM + wr * 64 + fr, col0 = u.pn * BM + wc * 32 + 8 * fq;
        const bool gel = (u.pn >= 4 && u.pn < 8);
#pragma unroll
        for (int ai = 0; ai < 2; ++ai)
#pragma unroll
            for (int m = 0; m < 4; ++m) { bf16_t* rowp = O + (size_t)(row0 + ai * HALF + m * 16) * ldc + col0;
#pragma unroll
                for (int bj = 0; bj < 2; ++bj) { f32x4 v0 = acc[ai][bj][m][0], v1 = acc[ai][bj][m][1];
                    if (gel) {
#pragma unroll
                        for (int i = 0; i < 4; ++i) { v0[i] = gelu_tanh(v0[i]); v1[i] = gelu_tanh(v1[i]); } }
                    u32x4 w; w.x = cvt_pk_bf16(v0[0], v0[1]); w.y = cvt_pk_bf16(v0[2], v0[3]); w.z = cvt_pk_bf16(v1[0], v1[1]); w.w = cvt_pk_bf16(v1[2], v1[3]);
                    *(u32x4*)(rowp + bj * HALF) = w; } }
    }
};
struct EpiRes {
    static constexpr bool PERM = false;
    const float* base; float* out; const float* gate; int ldc; int gstride;
    __device__ __forceinline__ void operator()(f32x4 (&acc)[2][2][4][2], const Unit& u, int wr, int wc, int fr, int fq) const {
        const int row0 = u.pm * BM + wr * 64 + fr, col0 = u.pn * BM + wc * 32 + 4 * fq;
        const float* g = gate + (size_t)(u.pm >> 3) * gstride;
        f32x4 gv[2][2];
#pragma unroll
        for (int bj = 0; bj < 2; ++bj)
#pragma unroll
            for (int n = 0; n < 2; ++n) gv[bj][n] = *(const f32x4*)(g + col0 + bj * HALF + n * 16);
#pragma unroll
        for (int ai = 0; ai < 2; ++ai)
#pragma unroll
            for (int m = 0; m < 4; ++m) { const size_t off = (size_t)(row0 + ai * HALF + m * 16) * ldc + col0;
#pragma unroll
                for (int bj = 0; bj < 2; ++bj)
#pragma unroll
                    for (int n = 0; n < 2; ++n) { const f32x4 b = *(const f32x4*)(base + off + bj * HALF + n * 16);
                        *(f32x4*)(out + off + bj * HALF + n * 16) = b + gv[bj][n] * acc[ai][bj][m][n]; } }
    }
};
struct EpiSwiglu {
    static constexpr bool PERM = true;
    bf16_t* O; int ldc;
    __device__ __forceinline__ void operator()(f32x4 (&acc)[2][2][4][2], const Unit& u, int wr, int wc, int fr, int fq) const {
        const int row0 = u.pm * BM + wr * 64 + fr, col0 = u.pn * HALF + wc * 32 + 8 * fq;
#pragma unroll
        for (int ai = 0; ai < 2; ++ai)
#pragma unroll
            for (int m = 0; m < 4; ++m) { bf16_t* rowp = O + (size_t)(row0 + ai * HALF + m * 16) * ldc + col0;
                f32x4 o0, o1;
#pragma unroll
                for (int i = 0; i < 4; ++i) { const float g0 = acc[ai][0][m][0][i], g1 = acc[ai][0][m][1][i];
                    o0[i] = g0 * fast_sigmoid(g0) * acc[ai][1][m][0][i]; o1[i] = g1 * fast_sigmoid(g1) * acc[ai][1][m][1][i]; }
                u32x4 w; w.x = cvt_pk_bf16(o0[0], o0[1]); w.y = cvt_pk_bf16(o0[2], o0[3]); w.z = cvt_pk_bf16(o1[0], o1[1]); w.w = cvt_pk_bf16(o1[2], o1[3]);
                *(u32x4*)rowp = w; }
    }
};
__device__ __forceinline__ float dpp_shr(float x, float fill, int d) {
    const int xi = __float_as_int(x), fi = __float_as_int(fill); int r;
    switch (d) { case 1: r = __builtin_amdgcn_update_dpp(fi, xi, 0x111, 0xf, 0xf, false); break; case 2: r = __builtin_amdgcn_update_dpp(fi, xi, 0x112, 0xf, 0xf, false); break;
                 case 4: r = __builtin_amdgcn_update_dpp(fi, xi, 0x114, 0xf, 0xf, false); break; default: r = __builtin_amdgcn_update_dpp(fi, xi, 0x118, 0xf, 0xf, false); break; }
    return __int_as_float(r);
}
struct EpiLora {
    static constexpr bool PERM = false;
    float* GD; float* AA; bf16_t* GG; const float* w0; const float* a0;
    __device__ __forceinline__ void operator()(f32x4 (&acc)[2][2][4][2], const Unit& u, int wr, int wc, int fr, int fq) const {
        const int row0 = u.pm * BM + wr * 64 + fr, blk = u.pn >> 2, col0 = (u.pn & 3) * BM + wc * 32 + 4 * fq;
        if (blk == 2) {
#pragma unroll
            for (int ai = 0; ai < 2; ++ai)
#pragma unroll
                for (int m = 0; m < 4; ++m) { const size_t off = (size_t)(row0 + ai * HALF + m * 16) * 1024 + col0;
#pragma unroll
                    for (int bj = 0; bj < 2; ++bj)
#pragma unroll
                        for (int n = 0; n < 2; ++n) { const f32x4 v = acc[ai][bj][m][n]; u32x2 w; w.x = cvt_pk_bf16(v[0], v[1]); w.y = cvt_pk_bf16(v[2], v[3]);
                            *(u32x2*)(GG + off + bj * HALF + n * 16) = w; } }
        } else if (blk == 1) {
            f32x4 bv[2][2];
#pragma unroll
            for (int bj = 0; bj < 2; ++bj)
#pragma unroll
                for (int n = 0; n < 2; ++n) bv[bj][n] = *(const f32x4*)(a0 + col0 + bj * HALF + n * 16);
#pragma unroll
            for (int ai = 0; ai < 2; ++ai)
#pragma unroll
                for (int m = 0; m < 4; ++m) { const size_t off = (size_t)(row0 + ai * HALF + m * 16) * 1024 + col0;
#pragma unroll
                    for (int bj = 0; bj < 2; ++bj)
#pragma unroll
                        for (int n = 0; n < 2; ++n) { f32x4 v = acc[ai][bj][m][n] + bv[bj][n];
#pragma unroll
                            for (int i = 0; i < 4; ++i) v[i] = fast_sigmoid(v[i]);
                            *(f32x4*)(AA + off + bj * HALF + n * 16) = v; } }
        } else {
            const int lane = fq * 16 + fr, bsrc = ((lane & 48) | 15) << 2;
#pragma unroll
            for (int bj = 0; bj < 2; ++bj)
#pragma unroll
                for (int n = 0; n < 2; ++n) { const f32x4 bv = *(const f32x4*)(w0 + col0 + bj * HALF + n * 16);
#pragma unroll
                    for (int ai = 0; ai < 2; ++ai) { f32x4 carry = (f32x4){0.f, 0.f, 0.f, 0.f};
#pragma unroll
                        for (int m = 0; m < 4; ++m) { f32x4 v = acc[ai][bj][m][n] + bv;
#pragma unroll
                            for (int i = 0; i < 4; ++i) { float x = -0.60653065971f * fast_sigmoid(v[i]);
#pragma unroll
                                for (int d = 1; d < 16; d <<= 1) x += dpp_shr(x, 0.0f, d);
                                x += carry[i]; v[i] = x; carry[i] = __int_as_float(__builtin_amdgcn_ds_bpermute(bsrc, __float_as_int(x))); }
                            *(f32x4*)(GD + (size_t)(row0 + ai * HALF + m * 16) * 1024 + col0 + bj * HALF + n * 16) = v; } } }
        }
    }
};
struct EpiLru {
    static constexpr bool PERM = false;
    const bf16_t* U; const float* ba; const float* bx; const float* lam; bf16_t* HLOC; bf16_t* PCUM; float* PSEG; float* HSEG;
    __device__ __forceinline__ void operator()(f32x4 (&acc)[2][2][4][2], const Unit& u, int wr, int wc, int fr, int fq) const {
        const int lane = fq * 16 + fr;
        const int c0 = u.z * 256 + u.pn * HALF + wc * 32 + 4 * fq;
        f32x4 ba4[2], bx4[2], c8[2];
#pragma unroll
        for (int n = 0; n < 2; ++n) { ba4[n] = *(const f32x4*)(ba + c0 + 16 * n); bx4[n] = *(const f32x4*)(bx + c0 + 16 * n); const f32x4 l = *(const f32x4*)(lam + c0 + 16 * n);
#pragma unroll
            for (int i = 0; i < 4; ++i) { const float z = -l[i]; c8[n][i] = 8.0f * (fmaxf(z, 0.f) + log1pf(__expf(-fabsf(z)))); } }
        const int bsrc = ((lane & 48) | 15) << 2;
#pragma unroll
        for (int ai = 0; ai < 2; ++ai) {
            const int t0 = u.pm * BM + ai * HALF + wr * 64;
            f32x4 cA[2], cB[2];
#pragma unroll
            for (int n = 0; n < 2; ++n) { cA[n] = (f32x4){1.f, 1.f, 1.f, 1.f}; cB[n] = (f32x4){0.f, 0.f, 0.f, 0.f}; }
#pragma unroll
            for (int m = 0; m < 4; ++m) { const int t = t0 + 16 * m + fr; const bool first = (t & 2047) == 0;
#pragma unroll
                for (int n = 0; n < 2; ++n) { const u32x2 uw = *(const u32x2*)(U + (size_t)t * 1024 + c0 + 16 * n);
                    const float uu[4] = {bf_lo(uw.x), bf_hi(uw.x), bf_lo(uw.y), bf_hi(uw.y)};
                    f32x4 A, B;
#pragma unroll
                    for (int i = 0; i < 4; ++i) { const float r = fast_sigmoid(acc[ai][0][m][n][i] + ba4[n][i]), ig = fast_sigmoid(acc[ai][1][m][n][i] + bx4[n][i]);
                        const float la = -c8[n][i] * r, a = __expf(la), x2 = 2.0f * la;
                        float om;
                        if (x2 > -0.25f) { float q = 1.0f / 5040.0f; q = q * x2 + 1.0f / 720.0f; q = q * x2 + 1.0f / 120.0f; q = q * x2 + 1.0f / 24.0f; q = q * x2 + 1.0f / 6.0f; q = q * x2 + 0.5f; q = q * x2 + 1.0f; om = -(q * x2); }
                        else om = 1.0f - a * a;
                        const float mult = first ? 1.0f : sqrtf(om);
                        float a_ = a, b_ = mult * ig * uu[i];
#pragma unroll
                        for (int d = 1; d < 16; d <<= 1) { const float ap = dpp_shr(a_, 1.0f, d), bp = dpp_shr(b_, 0.0f, d); b_ = a_ * bp + b_; a_ = a_ * ap; }
                        b_ = a_ * cB[n][i] + b_; a_ = a_ * cA[n][i];
                        A[i] = a_; B[i] = b_; }
#pragma unroll
                    for (int i = 0; i < 4; ++i) { cA[n][i] = __int_as_float(__builtin_amdgcn_ds_bpermute(bsrc, __float_as_int(A[i]))); cB[n][i] = __int_as_float(__builtin_amdgcn_ds_bpermute(bsrc, __float_as_int(B[i]))); }
                    u32x2 hw, pw; hw.x = cvt_pk_bf16(B[0], B[1]); hw.y = cvt_pk_bf16(B[2], B[3]); pw.x = cvt_pk_bf16(A[0], A[1]); pw.y = cvt_pk_bf16(A[2], A[3]);
                    *(u32x2*)(HLOC + (size_t)t * 1024 + c0 + 16 * n) = hw; *(u32x2*)(PCUM + (size_t)t * 1024 + c0 + 16 * n) = pw; } }
            if (fr == 0) { const int seg = t0 >> 6;
#pragma unroll
                for (int n = 0; n < 2; ++n) { *(f32x4*)(PSEG + (size_t)seg * 1024 + c0 + 16 * n) = cA[n]; *(f32x4*)(HSEG + (size_t)seg * 1024 + c0 + 16 * n) = cB[n]; } }
        }
    }
};

template <class Epi, class Sched, bool ALIGN_EPI = false>
__device__ __forceinline__ void gemm_phase(PG8_LAS unsigned char* lds, const Gemm g, const Sched& S, const Epi& E) {
    const int tid = threadIdx.x, wid = __builtin_amdgcn_readfirstlane(tid >> 6), lane = tid & 63, wr = wid >> 2, wc = wid & 3, fr = lane & 15, fq = lane >> 4;
    int K_ = g.K; asm volatile("" : "+s"(K_));
    const int K = K_, nt = K / BK;
    unsigned voffA[2], voffB[2];
#pragma unroll
    for (int i = 0; i < 2; ++i) { int R, C; stage_rc(tid * 16 + i * 8192, R, C); const int Rb = Epi::PERM ? ((R & ~31) + perm32(R & 31)) : R;
        voffA[i] = (unsigned)(R * g.lda + C) * 2u; voffB[i] = (unsigned)(Rb * g.ldb + C) * 2u; }
    const size_t kstep = (size_t)(BK * 2);
    const size_t hstepA = (size_t)HALF * g.lda * 2, hstepB = (size_t)HALF * g.ldb * 2;
    const size_t tstepA = 2 * hstepA, tstepB = 2 * hstepB;
    const unsigned ldsw = (unsigned)wid * 1024u;
    const int aoff = lds_byte(wr * 64 + fr, fq * 8), boff = lds_byte(wc * 32 + fr, fq * 8);
#define PG8_SA(b, h) (((b) * 2 + (h)) * HTB)
#define PG8_SB(b, h) ((4 + (b) * 2 + (h)) * HTB)
#define PG8_STAGE(bufoff, gbase, voff) do { _Pragma("unroll") for (int _i = 0; _i < 2; ++_i) \
        __builtin_amdgcn_global_load_lds((const unsigned*)((const char*)(gbase) + (voff)[_i]), (PG8_LAS unsigned*)(lds + (bufoff) + ldsw + _i * 8192), 16, 0, 0); } while (0)
#define PG8_LDA(dst, b, h) do { _Pragma("unroll") for (int m = 0; m < 4; ++m) _Pragma("unroll") for (int k = 0; k < 2; ++k) dst[m][k] = *(const PG8_LAS bf16x8*)(lds + PG8_SA(b, h) + aoff + m * 2048 + k * 1024); } while (0)
#define PG8_LDB(dst, b, h) do { _Pragma("unroll") for (int n = 0; n < 2; ++n) _Pragma("unroll") for (int k = 0; k < 2; ++k) dst[n][k] = *(const PG8_LAS bf16x8*)(lds + PG8_SB(b, h) + boff + n * 2048 + k * 1024); } while (0)
#define PG8_MMA(ai, bj, At, Bt) do { __builtin_amdgcn_s_setprio(1); _Pragma("unroll") for (int m = 0; m < 4; ++m) _Pragma("unroll") for (int n = 0; n < 2; ++n) _Pragma("unroll") for (int k = 0; k < 2; ++k) \
        acc[ai][bj][m][n] = __builtin_amdgcn_mfma_f32_16x16x32_bf16(Bt[n][k], At[m][k], acc[ai][bj][m][n], 0, 0, 0); __builtin_amdgcn_s_setprio(0); } while (0)
#define PG8_WAIT_V(n) asm volatile("s_waitcnt vmcnt(" #n ")" ::: "memory")
#define PG8_WAIT_L(n) asm volatile("s_waitcnt lgkmcnt(" #n ")" ::: "memory")
#define PG8_BAR __builtin_amdgcn_s_barrier()
#define PG8_SCHED __builtin_amdgcn_sched_barrier(0)
    Unit cur, nxt; int ui = 0;
    if (!S.next(0, cur)) return;
    f32x4 acc[2][2][4][2];
#pragma unroll
    for (int a = 0; a < 2; ++a)
#pragma unroll
        for (int b = 0; b < 2; ++b)
#pragma unroll
            for (int m = 0; m < 4; ++m)
#pragma unroll
                for (int n = 0; n < 2; ++n) acc[a][b][m][n] = (f32x4){0.f, 0.f, 0.f, 0.f};
    bf16x8 At[4][2], B0[2][2], B1[2][2];
    const char* cA = (const char*)(g.A + cur.z * g.zA) + (size_t)cur.pm * tstepA; const char* cB = (const char*)(g.Bt + cur.z * g.zB) + (size_t)cur.pn * tstepB;
    PG8_STAGE(PG8_SB(0, 0), cB, voffB); PG8_STAGE(PG8_SB(0, 1), cB + hstepB, voffB); PG8_STAGE(PG8_SA(0, 0), cA, voffA); PG8_STAGE(PG8_SA(0, 1), cA + hstepA, voffA);
    if (wr == 1) PG8_BAR;
    PG8_WAIT_V(2); PG8_BAR;
    PG8_STAGE(PG8_SB(1, 0), cB + kstep, voffB); PG8_STAGE(PG8_SA(1, 0), cA + kstep, voffA); PG8_STAGE(PG8_SB(1, 1), cB + hstepB + kstep, voffB);
    PG8_WAIT_V(6); PG8_BAR;
    for (;;) {
        const bool has_next = S.next(ui + 1, nxt);
        const char* nA = has_next ? (const char*)(g.A + nxt.z * g.zA) + (size_t)nxt.pm * tstepA : cA; const char* nB = has_next ? (const char*)(g.Bt + nxt.z * g.zB) + (size_t)nxt.pn * tstepB : cB;
        for (int t = 0; t < nt; t += 2) {
            const bool last = (t == nt - 2);
            const char* a1 = cA + (size_t)(t + 1) * kstep;
            const char* a2 = last ? nA : cA + (size_t)(t + 2) * kstep; const char* b2 = last ? nB : cB + (size_t)(t + 2) * kstep;
            const char* a3 = a2 + kstep; const char* b3 = b2 + kstep;
            PG8_LDB(B0, 0, 0); PG8_LDB(B1, 0, 1); PG8_SCHED; PG8_LDA(At, 0, 0); PG8_STAGE(PG8_SA(1, 1), a1 + hstepA, voffA);
            PG8_WAIT_V(8); PG8_WAIT_L(0); PG8_BAR; PG8_MMA(0, 0, At, B0); PG8_MMA(0, 1, At, B1); PG8_BAR; PG8_SCHED;
            PG8_LDA(At, 0, 1); PG8_STAGE(PG8_SB(0, 0), b2, voffB); PG8_STAGE(PG8_SB(0, 1), b2 + hstepB, voffB); PG8_STAGE(PG8_SA(0, 0), a2, voffA);
            PG8_WAIT_V(8); PG8_WAIT_L(0); PG8_BAR; PG8_MMA(1, 0, At, B0); PG8_MMA(1, 1, At, B1); PG8_BAR; PG8_SCHED;
            PG8_LDB(B0, 1, 0); PG8_LDB(B1, 1, 1); PG8_SCHED; PG8_LDA(At, 1, 0); PG8_STAGE(PG8_SA(0, 1), a2 + hstepA, voffA);
            PG8_WAIT_V(8); PG8_WAIT_L(0); PG8_BAR; PG8_MMA(0, 0, At, B0); PG8_MMA(0, 1, At, B1); PG8_BAR; PG8_SCHED;
            PG8_LDA(At, 1, 1); PG8_STAGE(PG8_SB(1, 0), b3, voffB); PG8_STAGE(PG8_SB(1, 1), b3 + hstepB, voffB); PG8_STAGE(PG8_SA(1, 0), a3, voffA);
            PG8_WAIT_V(8); PG8_WAIT_L(0); PG8_BAR; PG8_MMA(1, 0, At, B0); PG8_MMA(1, 1, At, B1); PG8_BAR; PG8_SCHED;
        }
        if constexpr (ALIGN_EPI) { if (wr == 0) PG8_BAR; }
        { int fr_ = fr, fq_ = fq; asm volatile("" : "+v"(fr_), "+v"(fq_));
          E(acc, cur, wr, wc, fr_, fq_); }
        if (!has_next) break;
#pragma unroll
        for (int a = 0; a < 2; ++a)
#pragma unroll
            for (int b = 0; b < 2; ++b)
#pragma unroll
                for (int m = 0; m < 4; ++m)
#pragma unroll
                    for (int n = 0; n < 2; ++n) acc[a][b][m][n] = (f32x4){0.f, 0.f, 0.f, 0.f};
        cur = nxt; cA = nA; cB = nB; ++ui;
        if constexpr (ALIGN_EPI) { if (wr == 1) PG8_BAR; }
    }
    PG8_WAIT_V(0);
    if constexpr (!ALIGN_EPI) { if (wr == 0) PG8_BAR; }
    PG8_BAR;
#undef PG8_SA
#undef PG8_SB
#undef PG8_STAGE
#undef PG8_LDA
#undef PG8_LDB
#undef PG8_MMA
#undef PG8_WAIT_V
#undef PG8_WAIT_L
#undef PG8_BAR
#undef PG8_SCHED
}
}

constexpr int NWAVES = 8;
constexpr int N_LAUNCHES = MK_N_LAUNCHES;
constexpr int PER_PHASE = 11;
constexpr int NB = 4, SEQ = 2048, DM = 2048, M = NB * SEQ;
constexpr int DL = 1024, DR = 1024, NH = 16, HD = 64;
constexpr int INW = 5408, INWP = 5632;
constexpr int PROJW = 3360;
constexpr int DFF = 5632, NMODC = 6 * DM;
constexpr int LK = 384;
constexpr int NSEG = M / 64;

constexpr size_t MiB = 1u << 20;
constexpr size_t WS_CTL = 0, CTL_ZERO_BYTES = 64 * 1024;
constexpr size_t WS_MODP = 1 * MiB;
constexpr size_t WS_MOD = 2 * MiB;
constexpr size_t WS_LRUW = 3 * MiB;
constexpr size_t WS_LORAW = 4 * MiB;
constexpr size_t WS_SEG = 7 * MiB;
constexpr size_t WS_WIN = 8 * MiB;
constexpr size_t WS_WOUT = 30 * MiB;
constexpr size_t WS_WGU = 38 * MiB;
constexpr size_t WS_WDN = 82 * MiB;
constexpr size_t WS_H = 104 * MiB;
constexpr size_t WS_U = 104 * MiB;
constexpr size_t WS_AL = 120 * MiB;
constexpr size_t WS_P = 136 * MiB;
constexpr size_t WS_GD = 224 * MiB;
constexpr size_t WS_AA = 256 * MiB;
constexpr size_t WS_GG = 288 * MiB;
constexpr size_t WS_HLOC = 304 * MiB;
constexpr size_t WS_PCUM = 320 * MiB;
constexpr size_t WS_MIX = 336 * MiB;
constexpr size_t WS_END = 368 * MiB;
constexpr int CW_BAR = 1024;

constexpr int RING_OFF = 0, RING_BYTES = 131072;
constexpr int LDSCTL_OFF = RING_BYTES, MISC_OFF = LDSCTL_OFF + 320;
constexpr int LDS_BYTES = 147456;

#define GAS __attribute__((address_space(1)))
#define LAS __attribute__((address_space(3)))
typedef unsigned short bf16;
typedef unsigned v4u __attribute__((ext_vector_type(4)));
typedef unsigned v2u __attribute__((ext_vector_type(2)));
typedef float f32x4 __attribute__((ext_vector_type(4)));
typedef float f32x2 __attribute__((ext_vector_type(2)));
typedef GAS unsigned gu32;
#define RLX_AGENT __ATOMIC_RELAXED, __HIP_MEMORY_SCOPE_AGENT
#define LDS_WAIT() asm volatile("s_waitcnt lgkmcnt(0)" ::: "memory")
__device__ __forceinline__ unsigned f2bf(float f) { unsigned u = __builtin_bit_cast(unsigned, f); return (u + 0x7fffu + ((u >> 16) & 1u)) >> 16; }
__device__ __forceinline__ unsigned pk2(float lo, float hi) { return pg8::cvt_pk_bf16(lo, hi); }
__device__ __forceinline__ float bflo(unsigned w) { return __uint_as_float(w << 16); }
__device__ __forceinline__ float bfhi(unsigned w) { return __uint_as_float(w & 0xffff0000u); }

#define XB_TMO      128
#define XB_XCNT(j)  (256  + 64 * (j))
#define XB_XSUB(j)  (1280 + 64 * (j))
#define XB_XGEN(j)  (2304 + 64 * (j))
#define XB_TOP      3328
#define XB_TOPGEN   3392
#define XCD_BAR_WORDS 3456
#define XB_SPIN_CAP (1u << 20)
__device__ __forceinline__ unsigned xb_ld(unsigned* p)              { return __hip_atomic_load(p, __ATOMIC_RELAXED, __HIP_MEMORY_SCOPE_AGENT); }
__device__ __forceinline__ unsigned xb_add(unsigned* p, unsigned v) { return __hip_atomic_fetch_add(p, v, __ATOMIC_RELAXED, __HIP_MEMORY_SCOPE_AGENT); }
__device__ __forceinline__ unsigned xb_xcc_id() { return (unsigned)__builtin_amdgcn_s_getreg((3 << 11) | 20) & 0xFu; }
#define XB_SPIN(cond, bar) do { unsigned _sp = 0; while (cond) { __builtin_amdgcn_s_sleep(1); \
    if ((++_sp & 255u) == 0u) { if (xb_ld(&(bar)[XB_TMO])) break; if (_sp > XB_SPIN_CAP) { atomicAdd(&(bar)[XB_TMO], 1u); break; } } } } while (0)
struct XcdBarrier { unsigned* bar; unsigned x; volatile LAS unsigned* st; };
__device__ __forceinline__ XcdBarrier xcd_barrier_post(unsigned* bar, volatile LAS unsigned* st) {
    XcdBarrier b; b.bar = bar; b.x = xb_xcc_id(); b.st = st;
    if (threadIdx.x == 0) (void)xb_add(&bar[XB_XCNT(b.x)], 1u);
    return b;
}
__device__ __forceinline__ void xcd_barrier_complete(unsigned* bar, unsigned x, unsigned& nloc, unsigned& nx) {
    const unsigned G = gridDim.x * gridDim.y * gridDim.z;
    unsigned sum, cnt, mine, sp = 0u;
    for (;;) {
        sum = 0u; cnt = 0u; mine = 0u;
#pragma unroll
        for (unsigned j = 0; j < 16; ++j) { const unsigned c = xb_ld(&bar[XB_XCNT(j)]); sum += c; cnt += (c > 0u) ? 1u : 0u; mine = (j == x) ? c : mine; }
        if (sum == G) break;
        __builtin_amdgcn_s_sleep(1);
        if ((++sp & 255u) == 0u) { if (xb_ld(&bar[XB_TMO])) break; if (sp > XB_SPIN_CAP) { atomicAdd(&bar[XB_TMO], 1u); break; } }
    }
    nloc = mine > 0u ? mine : 1u; nx = cnt > 0u ? cnt : 1u;
}
__device__ __forceinline__ void xcd_barrier(const XcdBarrier& b) {
    asm volatile("s_waitcnt vmcnt(0)" ::: "memory");
    __syncthreads();
    if (threadIdx.x == 0) {
        unsigned* bar = b.bar;
        __builtin_amdgcn_s_waitcnt(0);
        unsigned nloc = b.st[0], nx = b.st[1];
        if (nloc == 0u) { xcd_barrier_complete(bar, b.x, nloc, nx); b.st[0] = nloc; b.st[1] = nx; }
        const unsigned old = xb_add(&bar[XB_XSUB(b.x)], 1u);
        const unsigned gen = old / nloc;
        if (old + 1u == (gen + 1u) * nloc) {
            __builtin_amdgcn_fence(__ATOMIC_RELEASE, "agent");
            asm volatile("s_waitcnt vmcnt(0)" ::: "memory");
            const unsigned og = xb_add(&bar[XB_TOP], 1u);
            const unsigned tg = og / nx;
            if (og + 1u == (tg + 1u) * nx) xb_add(&bar[XB_TOPGEN], 1u);
            else XB_SPIN(xb_ld(&bar[XB_TOPGEN]) == tg, bar);
            __builtin_amdgcn_fence(__ATOMIC_ACQUIRE, "agent");
            xb_add(&bar[XB_XGEN(b.x)], 1u);
            asm volatile("s_waitcnt vmcnt(0)" ::: "memory");
        } else {
            XB_SPIN(xb_ld(&bar[XB_XGEN(b.x)]) == gen, bar);
            __builtin_amdgcn_fence(__ATOMIC_ACQUIRE, "agent");
            asm volatile("s_waitcnt vmcnt(0)" ::: "memory");
        }
    }
    __syncthreads();
}

struct Frame {
    LAS unsigned char* lds;
    int tid, lane, wave;
    int vcu, G;
};
struct Args { const float* in[29]; float* out; unsigned char* ws; int ph_lo, ph_hi; };

__device__ __forceinline__ float wave_sum(float v) {
#pragma unroll
    for (int o = 1; o < 64; o <<= 1) v += __shfl_xor(v, o);
    return v;
}
__device__ __forceinline__ void transpose_item(const float* W, int N, bf16* WT, int ldk, int k0, int n0, int drow0, LAS float* scr, int lane) {
#pragma unroll 8
    for (int i = 0; i < 32; ++i) { const int kk = 2 * i + (lane >> 5); scr[kk * 33 + (lane & 31)] = W[(size_t)(k0 + kk) * N + n0 + (lane & 31)]; }
    LDS_WAIT(); asm volatile("" ::: "memory");
    const int c = lane & 7;
#pragma unroll
    for (int j = 0; j < 4; ++j) { const int n = (lane >> 3) + 8 * j; const LAS float* s = scr + (8 * c) * 33 + n;
        v4u o; o.x = pk2(s[0 * 33], s[1 * 33]); o.y = pk2(s[2 * 33], s[3 * 33]); o.z = pk2(s[4 * 33], s[5 * 33]); o.w = pk2(s[6 * 33], s[7 * 33]);
        *(GAS v4u*)(WT + (size_t)(drow0 + n) * ldk + k0 + 8 * c) = o; }
    LDS_WAIT(); asm volatile("" ::: "memory");
}

constexpr int I_WIN = (DM / 64) * (INW / 32);
constexpr int I_WOUT = (DM / 64) * (DM / 32);
constexpr int I_LRU = 8 * 4 * 8;
constexpr int I_ZERO = INWP - INW;
constexpr int P0_ITEMS = I_WIN + I_WOUT + I_LRU + I_ZERO;
__device__ __forceinline__ void p0_item(const Args& a, int it, LAS float* scr, int lane) {
    unsigned char* ws = a.ws;
    if (it < I_WIN) { const int nblk = INW / 32, kb = it / nblk, nb = it % nblk; transpose_item(a.in[5], INW, (bf16*)(ws + WS_WIN), DM, 64 * kb, 32 * nb, 32 * nb, scr, lane); return; } it -= I_WIN;
    if (it < I_WOUT) { const int nblk = DM / 32, kb = it / nblk, nb = it % nblk; transpose_item(a.in[24], DM, (bf16*)(ws + WS_WOUT), DM, 64 * kb, 32 * nb, 32 * nb, scr, lane); return; } it -= I_WOUT;
    if (it < I_LRU) { const int hm = it >> 5, h = hm >> 1, mat = hm & 1, kb = (it >> 3) & 3, nb = it & 7, n0 = 32 * nb;
        const float* W = (mat ? a.in[10] : a.in[8]) + (size_t)h * 256 * 256;
        transpose_item(W, 256, (bf16*)(ws + WS_LRUW), 256, 64 * kb, n0, h * 512 + 256 * (n0 >> 7) + 128 * mat + (n0 & 127), scr, lane); return; } it -= I_LRU;
    { GAS v4u* o = (GAS v4u*)((bf16*)(ws + WS_WIN) + (size_t)(INW + it) * DM) + lane;
#pragma unroll
      for (int j = 0; j < 4; ++j) o[64 * j] = (v4u){0u, 0u, 0u, 0u}; }
}
__device__ __forceinline__ void p0_prologue(const Args& a, Frame& F) {
    const int wg = blockIdx.x;
    LAS float* scr = (LAS float*)(F.lds + RING_OFF + F.wave * 16384);
    if (wg < 192) {
        const int slab = wg % 48, ks = wg / 48, k0 = ks * 512 + F.wave * 64;
        const float* cin = a.in[1];
        float ca[4];
#pragma unroll
        for (int b = 0; b < 4; ++b) { const float c = cin[b * DM + k0 + F.lane]; ca[b] = c / (1.0f + __expf(-c)); }
        f32x4 acc[4];
#pragma unroll
        for (int b = 0; b < 4; ++b) acc[b] = (f32x4){0.f, 0.f, 0.f, 0.f};
        const GAS f32x4* wp = (const GAS f32x4*)(a.in[2] + (size_t)k0 * NMODC + slab * 256) + F.lane;
#pragma unroll 16
        for (int i = 0; i < 64; ++i) { const f32x4 w = wp[(size_t)i * (NMODC / 4)];
#pragma unroll
            for (int b = 0; b < 4; ++b) { const float s = __shfl(ca[b], i); acc[b] += w * s; } }
        LAS f32x4* red = (LAS f32x4*)(F.lds + RING_OFF);
#pragma unroll
        for (int b = 0; b < 4; ++b) red[(F.wave * 4 + b) * 64 + F.lane] = acc[b];
        __syncthreads();
        if (F.tid < 256) { const int b = F.tid >> 6, l = F.tid & 63; f32x4 s = red[(0 * 4 + b) * 64 + l];
#pragma unroll
            for (int w = 1; w < 8; ++w) s += red[(w * 4 + b) * 64 + l];
            *(GAS f32x4*)((float*)(a.ws + WS_MODP) + ((size_t)(ks * 4 + b) * NMODC + slab * 256 + l * 4)) = s; }
        __syncthreads();
    }
    if (wg >= 192) { for (int it = (wg - 192) * 8 + F.wave; it < 4096; it += 512) p0_item(a, it, scr, F.lane); }
    else { for (int it = 4096 + wg * 8 + F.wave; it < P0_ITEMS; it += 1536) p0_item(a, it, scr, F.lane); }
    { const int gt = wg * 512 + F.tid;
      for (int idx = gt; idx < 3 * 48 * 1024; idx += 256 * 512) { const int nn = idx & 1023, kc = (idx >> 10) % 48, blk = idx / (48 * 1024);
        const float* W = blk == 0 ? a.in[15] : (blk == 1 ? a.in[17] : a.in[18]);
        const int klo = blk == 0 ? 0 : (blk == 1 ? 64 : 128), khi = blk == 0 ? 64 : (blk == 1 ? 128 : 288);
        float v[8];
#pragma unroll
        for (int j = 0; j < 8; ++j) { const int k = 8 * kc + j; v[j] = (k >= klo && k < khi) ? W[(size_t)(k - klo) * 1024 + nn] : 0.f; }
        v4u o; o.x = pk2(v[0], v[1]); o.y = pk2(v[2], v[3]); o.z = pk2(v[4], v[5]); o.w = pk2(v[6], v[7]);
        *(GAS v4u*)((bf16*)(a.ws + WS_LORAW) + (size_t)(blk * 1024 + nn) * LK + 8 * kc) = o; } }
}

template <int MODE>
__device__ __forceinline__ void norm_phase(const Args& a, Frame& F) {
    LAS float* G1 = (LAS float*)(F.lds + RING_OFF);
    LAS float* S1 = G1 + DM;
    const int row0 = F.vcu * 32, b = row0 / SEQ;
    const float* gain = MODE == 0 ? a.in[4] : (MODE == 1 ? a.in[25] : a.in[28]);
    const float* modp = (const float*)(a.ws + WS_MODP); const float* mod = (const float*)(a.ws + WS_MOD); const float* bada = a.in[3];
    for (int k = F.tid; k < DM; k += 512) {
        float sh = 0.f, sc = 0.f;
        if (MODE == 0) { sh = bada[k]; sc = bada[DM + k];
#pragma unroll
            for (int ks = 0; ks < 4; ++ks) { sh += modp[(size_t)(ks * 4 + b) * NMODC + k]; sc += modp[(size_t)(ks * 4 + b) * NMODC + DM + k]; } }
        else if (MODE == 1) { sh = mod[(size_t)b * NMODC + 3 * DM + k]; sc = mod[(size_t)b * NMODC + 4 * DM + k]; }
        G1[k] = gain[k] * (1.0f + sc); S1[k] = sh;
    }
    if (MODE == 0 && F.tid < 192) { const int idx = blockIdx.x * 192 + F.tid, bb = idx / NMODC, j = idx % NMODC; float s = bada[j];
#pragma unroll
        for (int ks = 0; ks < 4; ++ks) s += modp[(size_t)(ks * 4 + bb) * NMODC + j];
        ((float*)(a.ws + WS_MOD))[idx] = s; }
    __syncthreads();
    const float* src = MODE == 0 ? a.in[0] : a.out;
    for (int rr = F.wave; rr < 32; rr += NWAVES) {
        const int row = row0 + rr;
        const GAS f32x4* xr = (const GAS f32x4*)(src + (size_t)row * DM) + F.lane;
        f32x4 v[8]; float s = 0.f;
#pragma unroll
        for (int j = 0; j < 8; ++j) { v[j] = xr[64 * j]; s += (v[j].x * v[j].x + v[j].y * v[j].y) + (v[j].z * v[j].z + v[j].w * v[j].w); }
        const float rstd = 1.0f / sqrtf(wave_sum(s) * (1.0f / DM) + 1e-6f);
        if (MODE == 2) { GAS f32x4* o = (GAS f32x4*)(a.out + (size_t)row * DM) + F.lane;
#pragma unroll
            for (int j = 0; j < 8; ++j) { const f32x4 g = *(LAS f32x4*)(G1 + 256 * j + 4 * F.lane); o[64 * j] = v[j] * rstd * g; } }
        else { GAS v2u* o = (GAS v2u*)((bf16*)(a.ws + WS_H) + (size_t)row * DM) + F.lane;
#pragma unroll
            for (int j = 0; j < 8; ++j) { const f32x4 g = *(LAS f32x4*)(G1 + 256 * j + 4 * F.lane), sh = *(LAS f32x4*)(S1 + 256 * j + 4 * F.lane);
                const f32x4 y = v[j] * rstd * g + sh; v2u w; w.x = pk2(y.x, y.y); w.y = pk2(y.z, y.w); o[64 * j] = w; } }
    }
    __syncthreads();
}

__device__ __forceinline__ void prep_phase(const Args& a, Frame& F) {
    const bf16* P = (const bf16*)(a.ws + WS_P); bf16* U = (bf16*)(a.ws + WS_U); bf16* AL = (bf16*)(a.ws + WS_AL);
    const int row0 = F.vcu * 32, tb0 = row0 & (SEQ - 1), c = 2 * F.tid;
    const float* cw = a.in[6]; const float* cb = a.in[7]; const float* mu = a.in[13];
    float w[4][2], bb[2];
#pragma unroll
    for (int k = 0; k < 4; ++k) { w[k][0] = cw[k * DL + c]; w[k][1] = cw[k * DL + c + 1]; }
    bb[0] = cb[c]; bb[1] = cb[c + 1];
    const bool lor = F.tid < LK / 2; const int j = 2 * F.tid;
    float m0 = 0.f, m1 = 0.f; if (lor && j < 288) { m0 = mu[3072 + j]; m1 = mu[3072 + j + 1]; }
    unsigned p3 = 0u, p2 = 0u, p1 = 0u, lp = 0u;
    if (tb0 != 0) { p3 = *(const GAS unsigned*)(P + (size_t)(row0 - 3) * INWP + c); p2 = *(const GAS unsigned*)(P + (size_t)(row0 - 2) * INWP + c); p1 = *(const GAS unsigned*)(P + (size_t)(row0 - 1) * INWP + c);
        if (lor && j < 288) lp = *(const GAS unsigned*)(P + (size_t)(row0 - 1) * INWP + 5120 + j); }
    for (int rr = 0; rr < 32; ++rr) { const int t = row0 + rr;
        const unsigned p0 = *(const GAS unsigned*)(P + (size_t)t * INWP + c);
        const float u0 = bb[0] + w[0][0] * bflo(p3) + w[1][0] * bflo(p2) + w[2][0] * bflo(p1) + w[3][0] * bflo(p0);
        const float u1 = bb[1] + w[0][1] * bfhi(p3) + w[1][1] * bfhi(p2) + w[2][1] * bfhi(p1) + w[3][1] * bfhi(p0);
        *(GAS unsigned*)(U + (size_t)t * DL + c) = pk2(u0, u1);
        p3 = p2; p2 = p1; p1 = p0;
        if (lor) { float o0 = 0.f, o1 = 0.f;
            if (j < 288) { const unsigned q = *(const GAS unsigned*)(P + (size_t)t * INWP + 5120 + j);
                const float x0 = bflo(q) + (bflo(lp) - bflo(q)) * m0, x1 = bfhi(q) + (bfhi(lp) - bfhi(q)) * m1; lp = q;
                if (j < 64) { o0 = 1.0f - 2.0f * __builtin_amdgcn_rcpf(1.0f + __builtin_amdgcn_exp2f(2.88539008178f * x0)); o1 = 1.0f - 2.0f * __builtin_amdgcn_rcpf(1.0f + __builtin_amdgcn_exp2f(2.88539008178f * x1)); }
                else if (j < 128) { o0 = x0; o1 = x1; }
                else { o0 = pg8::fast_sigmoid(x0); o1 = pg8::fast_sigmoid(x1); } }
            *(GAS unsigned*)(AL + (size_t)t * LK + j) = pk2(o0, o1); }
    }
}

constexpr int CT = 64;
constexpr int MS = 72;
constexpr int MATB = 64 * MS * 2;
typedef short bf16x8 __attribute__((ext_vector_type(8)));
__device__ __forceinline__ float dpp_x1(float x) { return __int_as_float(__builtin_amdgcn_update_dpp(0, __float_as_int(x), 0xB1, 0xf, 0xf, true)); }
__device__ __forceinline__ float dpp_x2(float x) { return __int_as_float(__builtin_amdgcn_update_dpp(0, __float_as_int(x), 0x4E, 0xf, 0xf, true)); }
__device__ __forceinline__ float dpp_hm(float x) { return __int_as_float(__builtin_amdgcn_update_dpp(0, __float_as_int(x), 0x141, 0xf, 0xf, true)); }
__device__ __forceinline__ float dpp_rm(float x) { return __int_as_float(__builtin_amdgcn_update_dpp(0, __float_as_int(x), 0x140, 0xf, 0xf, true)); }
__device__ __forceinline__ float red16(float x) { x += dpp_x1(x); x += dpp_x2(x); x += dpp_hm(x); x += dpp_rm(x); return x; }
__device__ __forceinline__ f32x4 unpack4(v2u w) { return (f32x4){bflo(w.x), bfhi(w.x), bflo(w.y), bfhi(w.y)}; }
__device__ __forceinline__ bf16x8 ldfrag(const LAS bf16* mat, int r0, int kk, int lr, int lq) { return *(const LAS bf16x8*)(mat + (r0 + lr) * MS + kk + 8 * lq); }
__device__ __forceinline__ f32x4 mm64(f32x4 acc, const LAS bf16* A, int ar0, const LAS bf16* B, int br0, int lr, int lq) {
    acc = __builtin_amdgcn_mfma_f32_16x16x32_bf16(ldfrag(A, ar0, 0, lr, lq), ldfrag(B, br0, 0, lr, lq), acc, 0, 0, 0);
    acc = __builtin_amdgcn_mfma_f32_16x16x32_bf16(ldfrag(A, ar0, 32, lr, lq), ldfrag(B, br0, 32, lr, lq), acc, 0, 0, 0);
    return acc;
}
__device__ __forceinline__ void st_tile(LAS bf16* Out, int i0, int j0, f32x4 v, int lr, int lq) {
    v2u w; w.x = pg8::cvt_pk_bf16(v.x, v.y); w.y = pg8::cvt_pk_bf16(v.z, v.w); *(LAS v2u*)(Out + (i0 + lr) * MS + j0 + 4 * lq) = w; }

struct RwkvLoad { v2u pr, pk, pv, qr, qk, qv; f32x4 aa, g, gp; };
__device__ __forceinline__ void rwkv_issue(const Args& a, int bh, int tl, int jq, RwkvLoad& L) {
    const int b = bh >> 4, hd = bh & 15, t = b * SEQ + tl, cc = hd * 64 + 4 * jq;
    const bf16* P = (const bf16*)(a.ws + WS_P) + (size_t)t * INWP + 2048 + cc;
    L.pr = *(const GAS v2u*)(P); L.pk = *(const GAS v2u*)(P + 1024); L.pv = *(const GAS v2u*)(P + 2048);
    if (tl > 0) { L.qr = *(const GAS v2u*)(P - INWP); L.qk = *(const GAS v2u*)(P - INWP + 1024); L.qv = *(const GAS v2u*)(P - INWP + 2048); }
    else { L.qr = (v2u){0u, 0u}; L.qk = (v2u){0u, 0u}; L.qv = (v2u){0u, 0u}; }
    L.aa = *(const GAS f32x4*)((const float*)(a.ws + WS_AA) + (size_t)t * DR + cc);
    const float* G = (const float*)(a.ws + WS_GD) + (size_t)t * DR + cc;
    L.g = *(const GAS f32x4*)(G);
    if ((tl & (CT - 1)) != 0) L.gp = *(const GAS f32x4*)(G - DR); else L.gp = (f32x4){0.f, 0.f, 0.f, 0.f};
}
__device__ __forceinline__ f32x4 exp4(f32x4 x) { return (f32x4){__expf(x.x), __expf(x.y), __expf(x.z), __expf(x.w)}; }
__device__ __forceinline__ void st4(LAS bf16* p, f32x4 v) { v2u w; w.x = pg8::cvt_pk_bf16(v.x, v.y); w.y = pg8::cvt_pk_bf16(v.z, v.w); *(LAS v2u*)p = w; }
__device__ __forceinline__ void st4t(LAS bf16* p, f32x4 v) {
    const unsigned a = pg8::cvt_pk_bf16(v.x, v.y), b = pg8::cvt_pk_bf16(v.z, v.w);
    p[0] = (bf16)(a & 0xffffu); p[MS] = (bf16)(a >> 16); p[2 * MS] = (bf16)(b & 0xffffu); p[3 * MS] = (bf16)(b >> 16); }

__device__ __forceinline__ void rwkv_phase(const Args& a, Frame& F) {
    const int bh = blockIdx.x, b = bh >> 4, hd = bh & 15, tid = F.tid, w = F.wave, lr = F.lane & 15, lq = F.lane >> 4;
    LAS unsigned char* base = F.lds + RING_OFF;
#define MAT(i) ((LAS bf16*)(base + (i) * MATB))
    LAS bf16* const AH = MAT(0); LAS bf16* const RH = MAT(1); LAS bf16* const BT = MAT(2); LAS bf16* const KT = MAT(3); LAS bf16* const KHT = MAT(4); LAS bf16* const BHT = MAT(5); LAS bf16* const VT = MAT(6);
    LAS bf16* const LK = MAT(7); LAS bf16* const MK = MAT(8); LAS bf16* const MB = MAT(9); LAS bf16* const PA = MAT(10); LAS bf16* const PTA = MAT(11); LAS bf16* const TA = MAT(12); LAS bf16* const HT = MAT(13);
    LAS bf16* const PB = BT; LAS bf16* const PTB = KT; LAS bf16* const TB = LK; LAS bf16* const ZT = MK; LAS bf16* const UT = PA;
    LAS float* const YB = (LAS float*)(base + 2 * MATB);
    LAS float* const GC = (LAS float*)(base + 14 * MATB);
    LAS float* const RK = GC + 64;
#undef MAT
    const int tt = tid >> 4, jq = tid & 15, cc = hd * 64 + 4 * jq;
    const f32x4 mur = *(const GAS f32x4*)(a.in[13] + cc), muk = *(const GAS f32x4*)(a.in[13] + 1024 + cc), muv = *(const GAS f32x4*)(a.in[13] + 2048 + cc);
    const f32x4 kkw = *(const GAS f32x4*)(a.in[19] + cc), kaw = *(const GAS f32x4*)(a.in[20] + cc), rkw = *(const GAS f32x4*)(a.in[21] + cc);
    for (int i = tid; i < MATB / 4; i += 512) ((LAS unsigned*)HT)[i] = 0u;
    f32x4 hacc[2];
    hacc[0] = (f32x4){0.f, 0.f, 0.f, 0.f}; hacc[1] = hacc[0];
    RwkvLoad L0, L1;
    rwkv_issue(a, bh, tt, jq, L0); rwkv_issue(a, bh, tt + 32, jq, L1);
    f32x4 gcl = *(const GAS f32x4*)((const float*)(a.ws + WS_GD) + (size_t)(b * SEQ + CT - 1) * DR + cc);
    constexpr int NCH = SEQ / CT;
    for (int ch = 0; ch < NCH; ++ch) {
#pragma unroll
        for (int h2 = 0; h2 < 2; ++h2) { const RwkvLoad& L = h2 ? L1 : L0; const int t = tt + 32 * h2;
            const f32x4 pr = unpack4(L.pr), pk = unpack4(L.pk), pv = unpack4(L.pv), qr = unpack4(L.qr), qk = unpack4(L.qk), qv = unpack4(L.qv);
            const f32x4 xr = pr + (qr - pr) * mur, xk = pk + (qk - pk) * muk, xv = pv + (qv - pv) * muv;
            const f32x4 kr = xk * kkw;
            const float ss = red16((kr.x * kr.x + kr.y * kr.y) + (kr.z * kr.z + kr.w * kr.w));
            const float inv = 1.0f / fmaxf(sqrtf(ss), 1e-12f);
            const f32x4 kk = kr * inv, be = kk * L.aa;
            const f32x4 km = xk * (1.0f + (L.aa - 1.0f) * kaw);
            const f32x4 rkp = xr * km * rkw;
            const float rk = red16((rkp.x + rkp.y) + (rkp.z + rkp.w));
            const f32x4 eg = exp4(L.g), egp = exp4(L.gp), eng = exp4(-L.g), ec = exp4(gcl - L.g);
            st4(AH + t * MS + 4 * jq, -kk * egp); st4(RH + t * MS + 4 * jq, xr * eg); st4(BT + t * MS + 4 * jq, be * eng); st4(KT + t * MS + 4 * jq, km * eng);
            st4t(KHT + (4 * jq) * MS + t, km * ec); st4t(BHT + (4 * jq) * MS + t, be * ec); st4t(VT + (4 * jq) * MS + t, xv);
            if (jq == 0) RK[t] = rk;
            if (t == 0) *(LAS f32x4*)(GC + 4 * jq) = exp4(gcl);
        }
        if (ch + 1 < NCH) { const int tl = (ch + 1) * CT + tt; rwkv_issue(a, bh, tl, jq, L0); rwkv_issue(a, bh, tl + 32, jq, L1);
            gcl = *(const GAS f32x4*)((const float*)(a.ws + WS_GD) + (size_t)(b * SEQ + (ch + 2) * CT - 1) * DR + cc); }
        __syncthreads();
        f32x4 zacc[2], yacc[2], hadd[2], tacc[2];
        const f32x4 zero4 = (f32x4){0.f, 0.f, 0.f, 0.f};
#pragma unroll
        for (int e = 0; e < 2; ++e) { const int idx = 2 * w + e, i0 = 16 * (idx >> 2), j0 = 16 * (idx & 3);
            const int ti = i0 + lr, sj = j0 + 4 * lq;
            f32x4 lb = mm64(zero4, BT, j0, AH, i0, lr, lq), t0;
#pragma unroll
            for (int r = 0; r < 4; ++r) { lb[r] = (sj + r < ti) ? lb[r] : 0.f; t0[r] = (sj + r == ti) ? 1.0f : lb[r]; }
            st_tile(PA, i0, j0, lb, lr, lq); st_tile(TA, i0, j0, t0, lr, lq); tacc[e] = t0;
            f32x4 lbt = mm64(zero4, AH, j0, BT, i0, lr, lq);
#pragma unroll
            for (int r = 0; r < 4; ++r) lbt[r] = (ti < sj + r) ? lbt[r] : 0.f;
            st_tile(PTA, i0, j0, lbt, lr, lq);
            f32x4 lk = mm64(zero4, KT, j0, AH, i0, lr, lq), mk = mm64(zero4, KT, j0, RH, i0, lr, lq), mb = mm64(zero4, BT, j0, RH, i0, lr, lq);
#pragma unroll
            for (int r = 0; r < 4; ++r) { lk[r] = (sj + r < ti) ? lk[r] : 0.f; mk[r] = (sj + r <= ti) ? mk[r] : 0.f; mb[r] = (sj + r <= ti) ? mb[r] : 0.f; }
            st_tile(LK, i0, j0, lk, lr, lq); st_tile(MK, i0, j0, mk, lr, lq); st_tile(MB, i0, j0, mb, lr, lq);
        }
        __syncthreads();
#pragma unroll
        for (int e = 0; e < 2; ++e) { const int idx = 2 * w + e, i0 = 16 * (idx >> 2), j0 = 16 * (idx & 3);
            zacc[e] = mm64(zero4, LK, j0, VT, i0, lr, lq); yacc[e] = mm64(zero4, MK, j0, VT, i0, lr, lq); hadd[e] = mm64(zero4, KHT, j0, VT, i0, lr, lq);
            st_tile(PB, i0, j0, mm64(zero4, PTA, j0, PA, i0, lr, lq), lr, lq); st_tile(PTB, i0, j0, mm64(zero4, PA, j0, PTA, i0, lr, lq), lr, lq);
        }
        __syncthreads();
#pragma unroll
        for (int e = 0; e < 2; ++e) { const int idx = 2 * w + e, i0 = 16 * (idx >> 2), j0 = 16 * (idx & 3);
            st_tile(PA, i0, j0, mm64(zero4, PTB, j0, PB, i0, lr, lq), lr, lq); st_tile(PTA, i0, j0, mm64(zero4, PB, j0, PTB, i0, lr, lq), lr, lq);
            tacc[e] = mm64(tacc[e], PTB, j0, TA, i0, lr, lq); st_tile(TB, i0, j0, tacc[e], lr, lq);
            zacc[e] = mm64(zacc[e], AH, j0, HT, i0, lr, lq); st_tile(ZT, i0, j0, zacc[e], lr, lq);
        }
        __syncthreads();
#pragma unroll
        for (int e = 0; e < 2; ++e) { const int idx = 2 * w + e, i0 = 16 * (idx >> 2), j0 = 16 * (idx & 3);
            st_tile(PB, i0, j0, mm64(zero4, PTA, j0, PA, i0, lr, lq), lr, lq); st_tile(PTB, i0, j0, mm64(zero4, PA, j0, PTA, i0, lr, lq), lr, lq);
            tacc[e] = mm64(tacc[e], PTA, j0, TB, i0, lr, lq); st_tile(TA, i0, j0, tacc[e], lr, lq);
        }
        __syncthreads();
#pragma unroll
        for (int e = 0; e < 2; ++e) { const int idx = 2 * w + e, i0 = 16 * (idx >> 2), j0 = 16 * (idx & 3);
            st_tile(PA, i0, j0, mm64(zero4, PTB, j0, PB, i0, lr, lq), lr, lq); st_tile(PTA, i0, j0, mm64(zero4, PB, j0, PTB, i0, lr, lq), lr, lq);
            tacc[e] = mm64(tacc[e], PTB, j0, TA, i0, lr, lq); st_tile(TB, i0, j0, tacc[e], lr, lq);
        }
        __syncthreads();
#pragma unroll
        for (int e = 0; e < 2; ++e) { const int idx = 2 * w + e, i0 = 16 * (idx >> 2), j0 = 16 * (idx & 3);
            st_tile(PB, i0, j0, mm64(zero4, PTA, j0, PA, i0, lr, lq), lr, lq); st_tile(PTB, i0, j0, mm64(zero4, PA, j0, PTA, i0, lr, lq), lr, lq);
            tacc[e] = mm64(tacc[e], PTA, j0, TB, i0, lr, lq); st_tile(TA, i0, j0, tacc[e], lr, lq);
        }
        __syncthreads();
#pragma unroll
        for (int e = 0; e < 2; ++e) { const int idx = 2 * w + e, i0 = 16 * (idx >> 2), j0 = 16 * (idx & 3);
            tacc[e] = mm64(tacc[e], PTB, j0, TA, i0, lr, lq); st_tile(TB, i0, j0, tacc[e], lr, lq);
        }
        __syncthreads();
#pragma unroll
        for (int e = 0; e < 2; ++e) { const int idx = 2 * w + e, i0 = 16 * (idx >> 2), j0 = 16 * (idx & 3);
            st_tile(UT, i0, j0, mm64(zero4, TB, j0, ZT, i0, lr, lq), lr, lq);
        }
        __syncthreads();
#pragma unroll
        for (int e = 0; e < 2; ++e) { const int idx = 2 * w + e, i0 = 16 * (idx >> 2), j0 = 16 * (idx & 3);
            yacc[e] = mm64(yacc[e], RH, j0, HT, i0, lr, lq); yacc[e] = mm64(yacc[e], MB, j0, UT, i0, lr, lq);
#pragma unroll
            for (int r = 0; r < 4; ++r) YB[(j0 + 4 * lq + r) * 64 + i0 + lr] = yacc[e][r];
            const f32x4 gc4 = *(const LAS f32x4*)(GC + j0 + 4 * lq);
            hacc[e] = hacc[e] * gc4 + hadd[e]; hacc[e] = mm64(hacc[e], BHT, j0, UT, i0, lr, lq);
        }
        __syncthreads();
#pragma unroll
        for (int e = 0; e < 2; ++e) { const int idx = 2 * w + e, i0 = 16 * (idx >> 2), j0 = 16 * (idx & 3); st_tile(HT, i0, j0, hacc[e], lr, lq); }
        { const f32x4 lng = *(const GAS f32x4*)(a.in[22] + cc), lnb = *(const GAS f32x4*)(a.in[23] + cc);
#pragma unroll
          for (int h2 = 0; h2 < 2; ++h2) { const int t = tt + 32 * h2, tg = b * SEQ + ch * CT + t;
            const f32x4 y = *(const LAS f32x4*)(YB + t * 64 + 4 * jq);
            const float mean = red16((y.x + y.y) + (y.z + y.w)) * (1.0f / 64.0f);
            const f32x4 dy = y - mean;
            const float var = red16((dy.x * dy.x + dy.y * dy.y) + (dy.z * dy.z + dy.w * dy.w)) * (1.0f / 64.0f);
            const float rs = 1.0f / sqrtf(var + 64e-5f);
            const LAS bf16* vp = VT + (4 * jq) * MS + t;
            const f32x4 vv = (f32x4){__uint_as_float((unsigned)vp[0] << 16), __uint_as_float((unsigned)vp[MS] << 16), __uint_as_float((unsigned)vp[2 * MS] << 16), __uint_as_float((unsigned)vp[3 * MS] << 16)};
            const float rk = RK[t];
            const f32x4 g = unpack4(*(const GAS v2u*)((const bf16*)(a.ws + WS_GG) + (size_t)tg * DR + cc));
            const f32x4 o = (dy * rs * lng + lnb + vv * rk) * g;
            v2u ow; ow.x = pk2(o.x, o.y); ow.y = pk2(o.z, o.w);
            *(GAS v2u*)((bf16*)(a.ws + WS_MIX) + (size_t)tg * DM + DL + cc) = ow; } }
        __syncthreads();
    }
}

constexpr int I_WGU = (DM / 64) * (2 * DFF / 32);
constexpr int I_WDN = (DFF / 64) * (DM / 32);
__device__ __forceinline__ void p5_other(const Args& a, Frame& F) {
    const int ow = blockIdx.x - 64;
    unsigned char* ws = a.ws;
    if (ow < NSEG) { const int s = ow, sb = s & ~31, cq = F.tid & 255, rp = F.tid >> 8;
        const float* PS = (const float*)(ws + WS_SEG); const float* HS = PS + (size_t)NSEG * DL;
        f32x4 carry = (f32x4){0.f, 0.f, 0.f, 0.f};
        for (int s2 = sb; s2 < s; ++s2) { const f32x4 p = *(const GAS f32x4*)(PS + (size_t)s2 * DL + 4 * cq), h = *(const GAS f32x4*)(HS + (size_t)s2 * DL + 4 * cq); carry = p * carry + h; }
        for (int r = rp; r < 64; r += 2) { const size_t t = (size_t)s * 64 + r;
            const f32x4 hl = unpack4(*(const GAS v2u*)((const bf16*)(ws + WS_HLOC) + t * DL + 4 * cq)), pc = unpack4(*(const GAS v2u*)((const bf16*)(ws + WS_PCUM) + t * DL + 4 * cq));
            const f32x4 gt = unpack4(*(const GAS v2u*)((const bf16*)(ws + WS_P) + t * INWP + DL + 4 * cq));
            const f32x4 o = (hl + pc * carry) * gt; v2u w; w.x = pk2(o.x, o.y); w.y = pk2(o.z, o.w);
            *(GAS v2u*)((bf16*)(ws + WS_MIX) + t * DM + 4 * cq) = w; } }
    LAS float* scr = (LAS float*)(F.lds + RING_OFF + F.wave * 16384);
    for (int it = ow * 8 + F.wave; it < I_WGU + I_WDN; it += 192 * 8) {
        if (it < I_WGU) { const int nblk = 2 * DFF / 32, kb = it / nblk, nb = it % nblk, n0 = 32 * nb, mat = n0 >= DFF ? 1 : 0, f0 = n0 - mat * DFF;
            transpose_item(a.in[26], 2 * DFF, (bf16*)(ws + WS_WGU), DM, 64 * kb, n0, 256 * (f0 >> 7) + 128 * mat + (f0 & 127), scr, F.lane); }
        else { const int i2 = it - I_WGU, nblk = DM / 32, kb = i2 / nblk, nb = i2 % nblk; transpose_item(a.in[27], DM, (bf16*)(ws + WS_WDN), DFF, 64 * kb, 32 * nb, 32 * nb, scr, F.lane); }
    }
}

__global__ void __launch_bounds__(NWAVES * 64, 2) hybrid_fwd(Args args) {
    extern __shared__ __attribute__((aligned(16))) unsigned char lds[];
    Frame F;
    F.lds = (LAS unsigned char*)lds;
    F.tid = threadIdx.x; F.lane = F.tid & 63; F.wave = __builtin_amdgcn_readfirstlane(F.tid >> 6);
    F.G = gridDim.x; { const int bx = blockIdx.x; F.vcu = (bx % 8) * (F.G / 8) + bx / 8; }
    unsigned char* ws = args.ws;
    gu32* ctl = (gu32*)(ws + WS_CTL);
    for (int u = F.tid; u < (LDS_BYTES - LDSCTL_OFF) / 4; u += NWAVES * 64) ((LAS unsigned*)(F.lds + LDSCTL_OFF))[u] = 0u;
    __syncthreads();
    XcdBarrier bar; bar.bar = (unsigned*)(ctl + CW_BAR); bar.x = 0; bar.st = nullptr;
    if (N_LAUNCHES == 1) bar = xcd_barrier_post((unsigned*)(ctl + CW_BAR), (volatile LAS unsigned*)(F.lds + MISC_OFF) + 8);
    const int lo = args.ph_lo, hi = args.ph_hi;
#define IN(k) (lo <= (k) && (k) < hi)
#define REPB(k) for (int rep_ = 0; rep_ < ((k) == PROBE_PHASE ? PROBE_REPS : 1); ++rep_)
#define REPE(k) if ((k) == PROBE_PHASE && rep_ + 1 < PROBE_REPS) xcd_barrier(bar);
#define SEAM(k) do { if (IN(k) && IN((k) + 1)) xcd_barrier(bar); } while (0)
    typedef pg8::bf16_t b16;

    if (IN(0)) REPB(0) { p0_prologue(args, F); REPE(0) } SEAM(0);
    if (IN(1)) REPB(1) { norm_phase<0>(args, F); REPE(1) } SEAM(1);
    if (IN(2)) REPB(2) {
        pg8::Gemm g{(const b16*)(ws + WS_H), (const b16*)(ws + WS_WIN), DM, DM, DM, 0, 0}; pg8::StaticOrder S; S.init(M, INWP, F.G, (int)blockIdx.x);
        pg8::EpiP E{(b16*)(ws + WS_P), INWP};
        pg8::gemm_phase<pg8::EpiP, pg8::StaticOrder, true>(F.lds + RING_OFF, g, S, E);
        REPE(2)
    } SEAM(2);
    if (IN(3)) REPB(3) { prep_phase(args, F); REPE(3) } SEAM(3);
    if (IN(4)) {
        REPB(40) { pg8::Gemm g{(const b16*)(ws + WS_U), (const b16*)(ws + WS_LRUW), DL, 256, 256, 256, 512 * 256}; pg8::LruOrder S{F.G, (int)blockIdx.x};
          pg8::EpiLru E{(const b16*)(ws + WS_U), args.in[9], args.in[11], args.in[12], (b16*)(ws + WS_HLOC), (b16*)(ws + WS_PCUM), (float*)(ws + WS_SEG), (float*)(ws + WS_SEG) + (size_t)NSEG * DL};
          pg8::gemm_phase<pg8::EpiLru, pg8::LruOrder, false>(F.lds + RING_OFF, g, S, E); REPE(40) }
        REPB(41) { pg8::Gemm g{(const b16*)(ws + WS_AL), (const b16*)(ws + WS_LORAW), LK, LK, LK, 0, 0}; pg8::StaticOrder S; S.init(M, 3072, F.G, (int)blockIdx.x);
          pg8::EpiLora E{(float*)(ws + WS_GD), (float*)(ws + WS_AA), (b16*)(ws + WS_GG), args.in[14], args.in[16]};
          pg8::gemm_phase<pg8::EpiLora, pg8::StaticOrder, true>(F.lds + RING_OFF, g, S, E); REPE(41) }
    } SEAM(4);
    if (IN(5)) REPB(5) { if (blockIdx.x < 64) rwkv_phase(args, F); else p5_other(args, F); REPE(5) } SEAM(5);
    if (IN(6)) REPB(6) {
        pg8::Gemm g{(const b16*)(ws + WS_MIX), (const b16*)(ws + WS_WOUT), DM, DM, DM, 0, 0}; pg8::StaticOrder S; S.init(M, DM, F.G, (int)blockIdx.x);
        pg8::EpiRes E{args.in[0], args.out, (const float*)(ws + WS_MOD) + 2 * DM, DM, NMODC};
        pg8::gemm_phase<pg8::EpiRes, pg8::StaticOrder, false>(F.lds + RING_OFF, g, S, E);
        REPE(6)
    } SEAM(6);
    if (IN(7)) REPB(7) { norm_phase<1>(args, F); REPE(7) } SEAM(7);
    if (IN(8)) REPB(8) {
        pg8::Gemm g{(const b16*)(ws + WS_H), (const b16*)(ws + WS_WGU), DM, DM, DM, 0, 0}; pg8::StaticOrder S; S.init(M, 2 * DFF, F.G, (int)blockIdx.x);
        pg8::EpiSwiglu E{(b16*)(ws + WS_P), DFF};
        pg8::gemm_phase<pg8::EpiSwiglu, pg8::StaticOrder, true>(F.lds + RING_OFF, g, S, E);
        REPE(8)
    } SEAM(8);
    if (IN(9)) REPB(9) {
        pg8::Gemm g{(const b16*)(ws + WS_P), (const b16*)(ws + WS_WDN), DFF, DFF, DFF, 0, 0}; pg8::StaticOrder S; S.init(M, DM, F.G, (int)blockIdx.x);
        pg8::EpiRes E{args.out, args.out, (const float*)(ws + WS_MOD) + 5 * DM, DM, NMODC};
        pg8::gemm_phase<pg8::EpiRes, pg8::StaticOrder, false>(F.lds + RING_OFF, g, S, E);
    } SEAM(9);
    if (IN(10)) REPB(10) { norm_phase<2>(args, F); }
#undef IN
#undef SEAM
}

extern "C" void kernel_launch(void* const* d_in, const int* in_sizes, int n_in, void* d_out, int out_size, void* d_ws, size_t ws_size, hipStream_t stream) {
    static int grid = 0;
    if (grid == 0) {
        if (n_in != 29 || in_sizes[0] != M * DM || out_size != M * DM || ws_size < WS_END) {
            fprintf(stderr, "kernel_launch: unexpected shapes: n_in %d in0 %d out %d ws %zu (need %zu)\n", n_in, n_in > 0 ? in_sizes[0] : -1, out_size, ws_size, (size_t)WS_END); grid = -1; return; }
        int dev = 0, cus = 0, per_cu = 0;
        if (hipGetDevice(&dev) != hipSuccess || hipDeviceGetAttribute(&cus, hipDeviceAttributeMultiprocessorCount, dev) != hipSuccess) { grid = -1; return; }
        if (hipFuncSetAttribute((const void*)hybrid_fwd, hipFuncAttributeMaxDynamicSharedMemorySize, LDS_BYTES) != hipSuccess) { fprintf(stderr, "kernel_launch: hipFuncSetAttribute failed\n"); grid = -1; return; }
        if (hipOccupancyMaxActiveBlocksPerMultiprocessor(&per_cu, (const void*)hybrid_fwd, NWAVES * 64, LDS_BYTES) != hipSuccess || per_cu < 1) {
            fprintf(stderr, "kernel_launch: occupancy query reports %d workgroups per CU\n", per_cu); (void)hipGetLastError(); grid = -1; return; }
        grid = cus;
        if (grid != 256) { fprintf(stderr, "kernel_launch: built for a 256-CU device, found %d CUs\n", cus); grid = -1; return; }
    }
    if (grid < 0) return;
    (void)hipMemsetAsync((char*)d_ws + WS_CTL, 0, CTL_ZERO_BYTES, stream);
    Args a{};
    for (int i = 0; i < 29; ++i) a.in[i] = (const float*)d_in[i];
    a.out = (float*)d_out; a.ws = (unsigned char*)d_ws;
    if (N_LAUNCHES == 1) {
        a.ph_lo = 0; a.ph_hi = PER_PHASE;
        void* kargs[] = {&a};
        hipError_t e = hipLaunchCooperativeKernel((const void*)hybrid_fwd, dim3(grid), dim3(NWAVES * 64), kargs, LDS_BYTES, stream);
        if (e != hipSuccess) fprintf(stderr, "kernel_launch: cooperative launch failed: %s\n", hipGetErrorString(e));
    } else {
        for (int li = 0; li < PER_PHASE; ++li) { a.ph_lo = li; a.ph_hi = li + 1;
            hipLaunchKernelGGL(hybrid_fwd, dim3(grid), dim3(NWAVES * 64), LDS_BYTES, stream, a); }
    }
}
```
